# Optimizing an MI355X kernel written in HIP

```python
import math
import jax, jax.numpy as jnp
from jax import lax
import numpy as np

D_MODEL = 2048
BATCH = 4
SEQ = 4096
DEPTH = 1

HG_HEADS = 8
HG_KDIM = 128
HG_VDIM = 128
HG_WIDTH = HG_HEADS * HG_VDIM
HG_FDIM = HG_HEADS * HG_KDIM
HG_CHUNK = 64

NSA_HEADS = 16
NSA_GROUPS = 4
NSA_HPG = NSA_HEADS // NSA_GROUPS
NSA_DH = 64
NSA_WIDTH = NSA_HEADS * NSA_DH
NSA_KV = NSA_GROUPS * NSA_DH
CMP_LEN = 32
CMP_STRIDE = 16
CMP_HIDDEN = 256
SLC_LEN = 64
SLC_TOPK = 16
WIN = 512
NSA_QBLOCK = 64

MIX_WIDTH = HG_WIDTH + NSA_WIDTH

REL_BUCKETS = 32
REL_MAX_DIST = 128

N_EXPERT_GROUPS = 8
EXPERTS_PER_GROUP = 8
N_EXPERTS = N_EXPERT_GROUPS * EXPERTS_PER_GROUP
EXPERT_TOPK = 2
EXPERT_DFF = 1024
MOE_BLOCK = 128

RMS_EPS = 1e-6
NEG_INF = -1e30
BIG = 1e9

IN_SIZES = (HG_FDIM, HG_FDIM, HG_WIDTH, HG_WIDTH,
            NSA_WIDTH, NSA_KV, NSA_KV, NSA_KV, NSA_KV, NSA_KV, NSA_KV, 3 * NSA_HEADS)
IN_COLS = 2 * HG_FDIM + 2 * HG_WIDTH + NSA_WIDTH + 6 * NSA_KV + 3 * NSA_HEADS

kernel_name = "hybrid_hgrn2_nsa_hmoe_block"


def rmsnorm(x, g):
    xf = x.astype(jnp.float32)
    y = xf * lax.rsqrt(jnp.mean(xf * xf, axis=-1, keepdims=True) + RMS_EPS)
    return (y * g.astype(jnp.float32)).astype(x.dtype)


def masked_softmax(logits, mask):
    logits = jnp.where(mask, logits.astype(jnp.float32), NEG_INF)
    p = jax.nn.softmax(logits, axis=-1)
    return p * mask.astype(p.dtype)


def rel_bucket(dist):
    n = jnp.maximum(dist, 0)
    max_exact = REL_BUCKETS // 2
    nf = jnp.maximum(n, 1).astype(jnp.float32)
    large = max_exact + (jnp.log(nf / max_exact) / math.log(REL_MAX_DIST / max_exact)
                         * (REL_BUCKETS - max_exact)).astype(jnp.int32)
    large = jnp.minimum(large, REL_BUCKETS - 1)
    return jnp.where(n < max_exact, n, large)


def hgrn2_mixer(q, f_logit, i_in, g_out, lower_bound, norm_g):
    B, S = q.shape[0], q.shape[1]
    nc = S // HG_CHUNK
    f32 = jnp.float32
    shp_k = (B, S, HG_HEADS, HG_KDIM)
    shp_v = (B, S, HG_HEADS, HG_VDIM)
    q = jax.nn.silu(q.reshape(shp_k).astype(f32))
    lb = lower_bound.reshape(HG_HEADS, HG_KDIM)
    f = lb + (1.0 - lb) * jax.nn.sigmoid(f_logit.reshape(shp_k).astype(f32))
    log_f = jnp.log(f)
    k = 1.0 - f
    v = i_in.reshape(shp_v).astype(f32)

    def chunks(t):
        return t.reshape(B, nc, HG_CHUNK, HG_HEADS, t.shape[-1]).transpose(1, 0, 3, 2, 4)

    causal = jnp.tril(jnp.ones((HG_CHUNK, HG_CHUNK), dtype=bool))[:, :, None]

    def step(state, inp):
        qc, kc, vc, lfc = inp
        b = jnp.cumsum(lfc, axis=2)
        decay = jnp.exp(jnp.where(causal, b[:, :, :, None, :] - b[:, :, None, :, :], NEG_INF))
        scores = jnp.einsum('bhtd,bhsd,bhtsd->bhts', qc, kc, decay)
        o = (jnp.einsum('bhts,bhsv->bhtv', scores, vc)
             + jnp.einsum('bhtd,bhdv->bhtv', qc * jnp.exp(b), state))
        b_last = b[:, :, -1:, :]
        state = (jnp.exp(b_last[:, :, 0, :, None]) * state
                 + jnp.einsum('bhsd,bhsv->bhdv', kc * jnp.exp(b_last - b), vc))
        return state, o

    s0 = jnp.zeros((B, HG_HEADS, HG_KDIM, HG_VDIM), f32)
    _, o = lax.scan(step, s0, (chunks(q), chunks(k), chunks(v), chunks(log_f)))
    o = o.transpose(1, 0, 3, 2, 4).reshape(shp_v)
    o = o * lax.rsqrt(jnp.mean(o * o, axis=-1, keepdims=True) + RMS_EPS) * norm_g.astype(f32)
    o = o * jax.nn.silu(g_out.reshape(shp_v).astype(f32))
    return o.reshape(B, S, HG_WIDTH)


def nsa_mixer(q, k_cmp, v_cmp, k_slc, v_slc, k_win, v_win, gate_logits,
              cmp_pe_k, cmp_w1_k, cmp_w2_k, cmp_pe_v, cmp_w1_v, cmp_w2_v, rel_bias):
    B, S = q.shape[0], q.shape[1]
    f32 = jnp.float32
    C = NSA_QBLOCK
    nq = S // C
    n_cmp = (S - CMP_LEN) // CMP_STRIDE + 1
    n_slc = S // SLC_LEN
    top_k = min(SLC_TOPK, n_slc)
    L = top_k * SLC_LEN

    def kv(t):
        return t.reshape(B, S, NSA_GROUPS, NSA_DH)

    cmp_idx = np.arange(n_cmp)[:, None] * CMP_STRIDE + np.arange(CMP_LEN)[None, :]
    cmp_end = jnp.asarray(cmp_idx[:, -1], jnp.int32)

    def compress(t, pe, w1, w2):
        blk = kv(t)[:, cmp_idx] + pe[None, None, :, None, :]
        blk = blk.transpose(0, 3, 1, 2, 4).reshape(B, NSA_GROUPS, n_cmp, CMP_LEN * NSA_DH)
        return jax.nn.silu(blk @ w1) @ w2

    kc = compress(k_cmp, cmp_pe_k, cmp_w1_k, cmp_w2_k)
    vc = compress(v_cmp, cmp_pe_v, cmp_w1_v, cmp_w2_v)

    ci = np.arange(n_cmp)[:, None] * CMP_STRIDE
    sj = np.arange(n_slc)[None, :] * SLC_LEN
    overlap = jnp.asarray(((ci <= sj + SLC_LEN - 1) & (ci + CMP_LEN - 1 >= sj)).astype(np.float32))

    def blocks(t):
        return kv(t).reshape(B, n_slc, SLC_LEN, NSA_GROUPS, NSA_DH).transpose(0, 3, 1, 2, 4)

    ks_blk = blocks(k_slc)
    vs_blk = blocks(v_slc)

    def pad_win(t):
        return jnp.pad(kv(t), ((0, 0), (WIN, 0), (0, 0), (0, 0))).transpose(0, 2, 1, 3)

    kw_pad = pad_win(k_win)
    vw_pad = pad_win(v_win)

    table = rel_bias.T.reshape(NSA_GROUPS, NSA_HPG, REL_BUCKETS)
    ii = np.arange(C)[:, None]
    jj = np.arange(WIN + C)[None, :]
    dist_w = WIN + ii - jj
    band = jnp.asarray((dist_w >= 0) & (dist_w < WIN))
    bias_w = table[:, :, rel_bucket(jnp.asarray(dist_w, jnp.int32))]
    g_idx = jnp.arange(NSA_GROUPS)[None, :, None, None, None]
    h_idx = jnp.arange(NSA_HPG)[None, None, :, None, None]
    gather = jax.vmap(jax.vmap(lambda blk, ix: blk[ix]))

    qb = (q.reshape(B, nq, C, NSA_GROUPS, NSA_HPG, NSA_DH) * NSA_DH ** -0.5).transpose(1, 0, 3, 4, 2, 5)
    gb = jax.nn.sigmoid(gate_logits.astype(f32)).reshape(
        B, nq, C, 3, NSA_GROUPS, NSA_HPG).transpose(1, 0, 4, 5, 2, 3)

    def query_block(args):
        c, qc, gc = args
        t_pos = c * C + jnp.arange(C, dtype=jnp.int32)
        s = (jnp.einsum('bghcd,bgnd->bghcn', qc, kc).astype(f32)
             + table[:, :, rel_bucket(t_pos[:, None] - cmp_end[None, :])])
        p_cmp = masked_softmax(s, cmp_end[None, :] <= t_pos[:, None])
        o_cmp = jnp.einsum('bghcn,bgnd->bghcd', p_cmp, vc)
        imp = jnp.einsum('bgcn,nj->bgcj', p_cmp.sum(axis=2), overlap)
        q_blk = t_pos[:, None] // SLC_LEN
        j = jnp.arange(n_slc)[None, :]
        forced = (j == 0) | (j == q_blk) | (j == q_blk - 1)
        imp = jnp.where(forced, BIG, jnp.where(j > q_blk, -BIG, imp))
        _, sel = lax.top_k(imp, top_k)
        k_sel = gather(ks_blk, sel).reshape(B, NSA_GROUPS, C, L, NSA_DH)
        v_sel = gather(vs_blk, sel).reshape(B, NSA_GROUPS, C, L, NSA_DH)
        pos_sel = (sel[..., None] * SLC_LEN + jnp.arange(SLC_LEN, dtype=jnp.int32)).reshape(B, NSA_GROUPS, C, L)
        dist = t_pos[:, None] - pos_sel
        s = (jnp.einsum('bghcd,bgcld->bghcl', qc, k_sel).astype(f32)
             + table[g_idx, h_idx, rel_bucket(dist)[:, :, None]])
        p = masked_softmax(s, (dist >= 0)[:, :, None])
        o_slc = jnp.einsum('bghcl,bgcld->bghcd', p, v_sel)
        kw = lax.dynamic_slice_in_dim(kw_pad, c * C, WIN + C, axis=2)
        vw = lax.dynamic_slice_in_dim(vw_pad, c * C, WIN + C, axis=2)
        valid = band & (jnp.arange(WIN + C, dtype=jnp.int32)[None, :] >= WIN - c * C)
        s = jnp.einsum('bghcd,bgld->bghcl', qc, kw).astype(f32) + bias_w
        p = masked_softmax(s, valid)
        o_win = jnp.einsum('bghcl,bgld->bghcd', p, vw)
        return gc[..., 0:1] * o_cmp + gc[..., 1:2] * o_slc + gc[..., 2:3] * o_win

    o = lax.map(query_block, (jnp.arange(nq, dtype=jnp.int32), qb, gb))
    return o.transpose(1, 0, 4, 2, 3, 5).reshape(B, S, NSA_WIDTH)


def hier_moe(h, w_rg, b_rg, w_re, b_re, w_gate, w_up, w_down):
    B, S, D = h.shape
    T = B * S
    A = T * EXPERT_TOPK
    f32 = jnp.float32
    xt = h.reshape(T, D)
    p_grp = jax.nn.softmax((xt @ w_rg).astype(f32) + b_rg.astype(f32), axis=-1)
    p_top, g_top = lax.top_k(p_grp, 1)
    le = ((xt @ w_re).astype(f32) + b_re.astype(f32)).reshape(T, N_EXPERT_GROUPS, EXPERTS_PER_GROUP)
    le = le[jnp.arange(T), g_top[:, 0]]
    top_v, top_i = lax.top_k(le, EXPERT_TOPK)
    gate = p_top * jax.nn.softmax(top_v, axis=-1)
    e_flat = (g_top * EXPERTS_PER_GROUP + top_i).reshape(A)
    tok_flat = jnp.arange(A, dtype=jnp.int32) // EXPERT_TOPK
    w_flat = gate.reshape(A)
    order = jnp.argsort(e_flat)
    e_s, tok_s, w_s = e_flat[order], tok_flat[order], w_flat[order]
    counts = jnp.bincount(e_flat, length=N_EXPERTS)
    offs = jnp.cumsum(counts) - counts
    padded = (counts + MOE_BLOCK - 1) // MOE_BLOCK * MOE_BLOCK
    pend = jnp.cumsum(padded)
    poffs = pend - padded
    dest = poffs[e_s] + (jnp.arange(A, dtype=jnp.int32) - offs[e_s])
    P = (A + MOE_BLOCK - 1) // MOE_BLOCK * MOE_BLOCK + N_EXPERTS * MOE_BLOCK
    n_blocks = P // MOE_BLOCK
    tok_buf = jnp.zeros((P,), jnp.int32).at[dest].set(tok_s)
    w_buf = jnp.zeros((P,), h.dtype).at[dest].set(w_s.astype(h.dtype))
    blk_start = jnp.arange(n_blocks, dtype=jnp.int32) * MOE_BLOCK
    blk_expert = jnp.minimum(jnp.searchsorted(pend, blk_start, side='right'), N_EXPERTS - 1)
    x_buf = xt[tok_buf].reshape(n_blocks, MOE_BLOCK, D)

    def expert_block(args):
        xb, e = args
        hid = jax.nn.silu(xb @ w_gate[e]) * (xb @ w_up[e])
        return hid @ w_down[e]

    y = lax.map(expert_block, (x_buf, blk_expert)).reshape(P, D)
    out = jnp.zeros((T, D), h.dtype).at[tok_buf].add((y * w_buf[:, None]).astype(h.dtype))
    return out.reshape(B, S, D)


def setup_inputs(seed: int = 0) -> dict:
    key = jax.random.key(seed)
    ks = jax.random.split(key, 24)
    f32 = jnp.float32

    def nrm(k, shape, scale):
        return jax.random.normal(k, shape, f32) * scale

    def gain(k, shape):
        return 1.0 + 0.02 * jax.random.normal(k, shape, f32)

    cmp_in = CMP_LEN * NSA_DH
    return {
        "x": nrm(ks[0], (BATCH, SEQ, D_MODEL), 1.0),
        "norm1_g": gain(ks[1], (DEPTH, D_MODEL)),
        "w_in": nrm(ks[2], (DEPTH, D_MODEL, IN_COLS), D_MODEL ** -0.5),
        "hg_lb_logits": nrm(ks[3], (DEPTH + 1, HG_FDIM), 0.5),
        "hg_norm_g": gain(ks[4], (DEPTH, HG_VDIM)),
        "cmp_pe_k": nrm(ks[5], (DEPTH, CMP_LEN, NSA_DH), 0.1),
        "cmp_w1_k": nrm(ks[6], (DEPTH, cmp_in, CMP_HIDDEN), cmp_in ** -0.5),
        "cmp_w2_k": nrm(ks[7], (DEPTH, CMP_HIDDEN, NSA_DH), CMP_HIDDEN ** -0.5),
        "cmp_pe_v": nrm(ks[8], (DEPTH, CMP_LEN, NSA_DH), 0.1),
        "cmp_w1_v": nrm(ks[9], (DEPTH, cmp_in, CMP_HIDDEN), cmp_in ** -0.5),
        "cmp_w2_v": nrm(ks[10], (DEPTH, CMP_HIDDEN, NSA_DH), CMP_HIDDEN ** -0.5),
        "rel_bias": nrm(ks[11], (REL_BUCKETS, NSA_HEADS), 0.5),
        "w_out": nrm(ks[12], (DEPTH, MIX_WIDTH, D_MODEL), MIX_WIDTH ** -0.5),
        "norm2_g": gain(ks[13], (DEPTH, D_MODEL)),
        "w_router_group": nrm(ks[14], (DEPTH, D_MODEL, N_EXPERT_GROUPS), D_MODEL ** -0.5),
        "b_router_group": nrm(ks[15], (DEPTH, N_EXPERT_GROUPS), 0.01),
        "w_router_expert": nrm(ks[16], (DEPTH, D_MODEL, N_EXPERTS), D_MODEL ** -0.5),
        "b_router_expert": nrm(ks[17], (DEPTH, N_EXPERTS), 0.01),
        "w_expert_gate": nrm(ks[18], (DEPTH, N_EXPERTS, D_MODEL, EXPERT_DFF), D_MODEL ** -0.5),
        "w_expert_up": nrm(ks[19], (DEPTH, N_EXPERTS, D_MODEL, EXPERT_DFF), D_MODEL ** -0.5),
        "w_expert_down": nrm(ks[20], (DEPTH, N_EXPERTS, EXPERT_DFF, D_MODEL), EXPERT_DFF ** -0.5),
        "final_norm_g": gain(ks[21], (D_MODEL,)),
    }


def reference(x, norm1_g, w_in, hg_lb_logits, hg_norm_g, cmp_pe_k, cmp_w1_k, cmp_w2_k,
              cmp_pe_v, cmp_w1_v, cmp_w2_v, rel_bias, w_out, norm2_g, w_router_group,
              b_router_group, w_router_expert, b_router_expert, w_expert_gate, w_expert_up,
              w_expert_down, final_norm_g):
    lower_bounds = jnp.cumsum(jax.nn.softmax(hg_lb_logits.astype(jnp.float32), axis=0), axis=0)
    split_at = np.cumsum(IN_SIZES)[:-1].tolist()
    for l in range(DEPTH):
        h = rmsnorm(x, norm1_g[l])
        (hq, hf, hi, hgate, nsa_q, kcm, vcm, ksl, vsl, kwn, vwn, nsa_gate) = jnp.split(
            h @ w_in[l], split_at, axis=-1)
        y_hg = hgrn2_mixer(hq, hf, hi, hgate, lower_bounds[l], hg_norm_g[l])
        y_nsa = nsa_mixer(nsa_q, kcm, vcm, ksl, vsl, kwn, vwn, nsa_gate,
                          cmp_pe_k[l], cmp_w1_k[l], cmp_w2_k[l],
                          cmp_pe_v[l], cmp_w1_v[l], cmp_w2_v[l], rel_bias)
        mix = jnp.concatenate([y_hg, y_nsa], axis=-1).astype(x.dtype)
        x = x + mix @ w_out[l]
        x = x + hier_moe(rmsnorm(x, norm2_g[l]), w_router_group[l], b_router_group[l],
                         w_router_expert[l], b_router_expert[l],
                         w_expert_gate[l], w_expert_up[l], w_expert_down[l])
    return rmsnorm(x, final_norm_g)
```

```cpp
#include <hip/hip_runtime.h>
#include <cstdio>
#include <cstdint>

#ifndef MK_ONE_LAUNCH
#define MK_ONE_LAUNCH 1
#endif

constexpr int D = 2048, NB = 4, S = 4096, T = NB * S;
constexpr int WIN_N = 6704;
constexpr int LDP = 6912;
constexpr int C_HQ = 0, C_HF = 1024, C_HI = 2048, C_HGATE = 3072, C_Q = 4096, C_KC = 5120, C_VC = 5376, C_KS = 5632, C_VS = 5888, C_KW = 6144, C_VW = 6400, C_GATE = 6656;
constexpr int NCMP = 255, NE = 64, DFF = 1024;
constexpr float EPS = 1e-6f;
constexpr int NTHR = 512;
constexpr int LDS_BYTES = 147456;
constexpr int PROWS = 49152;

constexpr size_t MiB = 1u << 20;
constexpr size_t WS_CTL = 0, CTL_BYTES = 1 * MiB;
constexpr size_t WS_LB = 1 * MiB;
constexpr size_t WS_BR = 1 * MiB + 65536;
constexpr size_t WS_LISTI = 16 * MiB;
constexpr size_t WS_LISTW = 20 * MiB;
constexpr size_t WS_WRT = 9 * MiB;
constexpr size_t WS_W1T = 10 * MiB;
constexpr size_t WS_W2T = 12 * MiB;
constexpr size_t WS_KCB = 13 * MiB;
constexpr size_t WS_VCB = 14 * MiB;
constexpr size_t WS_QH = 144 * MiB;
constexpr size_t WS_LOGF = 176 * MiB;
constexpr size_t WS_VH = 240 * MiB;
constexpr size_t WS_GH = 272 * MiB;
constexpr size_t WS_QN = 304 * MiB;
constexpr size_t WS_KV6 = 336 * MiB;
constexpr size_t WS_GATE = 384 * MiB;
constexpr size_t WS_HID = 144 * MiB;
constexpr size_t WS_Y2 = 240 * MiB;
constexpr size_t WS_XS = 368 * MiB;
constexpr size_t WS_SLOC = 1856 * MiB;
constexpr size_t WS_LSUM = 1872 * MiB;
constexpr size_t WS_MIXB = 640 * MiB;
constexpr size_t WS_X2 = 784 * MiB;
constexpr size_t WS_RLOG = 912 * MiB;
constexpr size_t WS_HB = 920 * MiB;
constexpr size_t WS_WINT = 984 * MiB;
constexpr size_t WS_WOUTT = 1012 * MiB;
constexpr size_t WS_WGUT = 1024 * MiB;
constexpr size_t WS_WDT = 1536 * MiB;
constexpr size_t WS_XNB = 1792 * MiB;
constexpr size_t WS_END = 1873 * MiB;
constexpr int CW_CNT = 65536, CNT_STRIDE = 64;
constexpr int CW_BAR = 4096;

#define LAS __attribute__((address_space(3)))
typedef float f32x4 __attribute__((ext_vector_type(4)));

struct Args { const float* in[22]; float* out; unsigned char* ws; int ph_lo, ph_hi, li, pad; };

#define XB_TMO      128
#define XB_XCNT(j)  (256  + 64 * (j))
#define XB_XSUB(j)  (1280 + 64 * (j))
#define XB_XGEN(j)  (2304 + 64 * (j))
#define XB_TOP      3328
#define XB_TOPGEN   3392
#define XCD_BAR_WORDS 3456
#define XB_SPIN_CAP (1u << 22)

__device__ __forceinline__ unsigned xb_ld(unsigned* p)              { return __hip_atomic_load(p, __ATOMIC_RELAXED, __HIP_MEMORY_SCOPE_AGENT); }
__device__ __forceinline__ unsigned xb_add(unsigned* p, unsigned v) { return __hip_atomic_fetch_add(p, v, __ATOMIC_RELAXED, __HIP_MEMORY_SCOPE_AGENT); }
__device__ __forceinline__ unsigned xb_xcc_id() { return (unsigned)__builtin_amdgcn_s_getreg((3 << 11) | 20) & 0xFu; }
#define XB_SPIN(cond, bar) do { unsigned _sp = 0; while (cond) { __builtin_amdgcn_s_sleep(1); \
    if ((++_sp & 255u) == 0u) { if (xb_ld(&(bar)[XB_TMO])) break; if (_sp > XB_SPIN_CAP) { atomicAdd(&(bar)[XB_TMO], 1u); break; } } } } while (0)

struct XcdBarrier { unsigned* bar; unsigned x; volatile LAS unsigned* st; int wave; };
__device__ __forceinline__ int lane_id() { return (int)__builtin_amdgcn_mbcnt_hi(~0u, __builtin_amdgcn_mbcnt_lo(~0u, 0u)); }

__device__ __forceinline__ XcdBarrier xcd_barrier_post(unsigned* bar, volatile LAS unsigned* st, int wave) {
    XcdBarrier b; b.bar = bar; b.x = xb_xcc_id(); b.st = st; b.wave = wave;
    if (b.wave == 0 && lane_id() == 0) (void)xb_add(&bar[XB_XCNT(b.x)], 1u);
    return b;
}
__device__ __forceinline__ void xcd_barrier_complete(unsigned* bar, unsigned x, unsigned& nloc, unsigned& nx) {
    const unsigned G = gridDim.x * gridDim.y * gridDim.z;
    unsigned sum, cnt, mine, sp = 0u;
    for (;;) {
        sum = 0u; cnt = 0u; mine = 0u;
#pragma unroll
        for (unsigned j = 0; j < 16; ++j) { const unsigned c = xb_ld(&bar[XB_XCNT(j)]); sum += c; cnt += (c > 0u) ? 1u : 0u; mine = (j == x) ? c : mine; }
        if (sum == G) break;
        __builtin_amdgcn_s_sleep(1);
        if ((++sp & 255u) == 0u) { if (xb_ld(&bar[XB_TMO])) break; if (sp > XB_SPIN_CAP) { atomicAdd(&bar[XB_TMO], 1u); break; } }
    }
    nloc = mine > 0u ? mine : 1u; nx = cnt > 0u ? cnt : 1u;
}
__device__ __forceinline__ void xcd_barrier(const XcdBarrier& b) {
    asm volatile("s_waitcnt vmcnt(0)" ::: "memory");
    __syncthreads();
    if (b.wave == 0 && lane_id() == 0) {
        unsigned* bar = b.bar;
        __builtin_amdgcn_s_waitcnt(0);
        unsigned nloc = b.st[0], nx = b.st[1];
        if (nloc == 0u) { xcd_barrier_complete(bar, b.x, nloc, nx); b.st[0] = nloc; b.st[1] = nx; }
        const unsigned old = xb_add(&bar[XB_XSUB(b.x)], 1u);
        const unsigned gen = old / nloc;
        if (old + 1u == (gen + 1u) * nloc) {
            __builtin_amdgcn_fence(__ATOMIC_RELEASE, "agent");
            asm volatile("s_waitcnt vmcnt(0)" ::: "memory");
            const unsigned og = xb_add(&bar[XB_TOP], 1u);
            const unsigned tg = og / nx;
            if (og + 1u == (tg + 1u) * nx) xb_add(&bar[XB_TOPGEN], 1u);
            else XB_SPIN(xb_ld(&bar[XB_TOPGEN]) == tg, bar);
            __builtin_amdgcn_fence(__ATOMIC_ACQUIRE, "agent");
            xb_add(&bar[XB_XGEN(b.x)], 1u);
            asm volatile("s_waitcnt vmcnt(0)" ::: "memory");
        } else {
            XB_SPIN(xb_ld(&bar[XB_XGEN(b.x)]) == gen, bar);
            __builtin_amdgcn_fence(__ATOMIC_ACQUIRE, "agent");
            asm volatile("s_waitcnt vmcnt(0)" ::: "memory");
        }
    }
    __syncthreads();
}

#ifndef MOE_TAIL_TEST
#define MOE_TAIL_TEST 0
#define MOE_TAIL_WAYS 4
#endif
namespace pg8 {
#define PG8_LAS __attribute__((address_space(3)))
typedef unsigned short bf16_t;
typedef short bf16x8 __attribute__((ext_vector_type(8)));
typedef float f32x4 __attribute__((ext_vector_type(4)));
typedef unsigned u32x4 __attribute__((ext_vector_type(4)));
typedef unsigned u32x2p __attribute__((ext_vector_type(2)));
constexpr int BM = 256, BK = 64, HALF = 128, HTB = HALF * BK * 2  , STAGE_BYTES = 8 * HTB, NXCD = 8, WGM = 8;

__host__ __device__ __forceinline__ int lds_byte(int r, int c) { const int st = (r >> 4) * 2 + (c >> 5), rr = r & 15, cc = c & 31, ob = rr * 64 + cc * 2; return st * 1024 + (ob ^ (((ob >> 9) & 1) << 5)); }
__host__ __device__ __forceinline__ void stage_rc(int b, int& R, int& C) { const int st = b / 1024, sb = b % 1024, swz = sb ^ (((sb >> 9) & 1) << 5); R = (st >> 1) * 16 + swz / 64; C = (st & 1) * 32 + (swz % 64) / 2; }
__host__ __device__ __forceinline__ int perm32(int rho) { const int n = rho >> 4, i = rho & 15; return 8 * (i >> 2) + 4 * n + (i & 3); }

struct Unit { int pm, pn, sub; };
struct Gemm { const bf16_t* A; const bf16_t* Bt; int M, N, K; };

struct StaticOrder {
    int nM, nN, nwg, G, c;
    __host__ __device__ void init(int M, int N, int G_, int c_) { nM = M / BM; nN = N / BM; nwg = nM * nN; G = G_; c = c_; }
    __host__ __device__ bool next(int i, Unit& u) const {
        const long L = (long)i * G + c; if (L >= nwg) return false;
        int wgid = (int)L; { const int q = nwg / NXCD, r = nwg % NXCD, xcd = wgid % NXCD, off = wgid / NXCD; wgid = (xcd < r ? xcd * (q + 1) : r * (q + 1) + (xcd - r) * q) + off; }
        const int nig = WGM * nN, gid = wgid / nig, fm = gid * WGM, gsz = (nM - fm) < WGM ? (nM - fm) : WGM;
        u.pm = fm + ((wgid % nig) % gsz); u.pn = (wgid % nig) / gsz; return true;
    }
    __device__ __forceinline__ void a_ready(const Unit&) const {}
    __device__ __forceinline__ void done(const Unit&) const {}
};


__device__ __forceinline__ unsigned cvt_pk_bf16(float lo, float hi) { unsigned r; asm volatile("v_cvt_pk_bf16_f32 %0, %1, %2" : "=v"(r) : "v"(lo), "v"(hi)); return r; }
struct EpiF32 {
    static constexpr bool PERM = false, AFTER_DRAIN = false;
    float* C; int ldc;
    __device__ __forceinline__ void operator()(const f32x4 (&acc)[2][2][4][2], const Unit& u, int wr, int wc, int fr, int fq) const {
        const int row0 = u.pm * BM + wr * 64 + fr, col0 = u.pn * BM + wc * 32 + 4 * fq;
#pragma unroll
        for (int ai = 0; ai < 2; ++ai)
#pragma unroll
            for (int m = 0; m < 4; ++m) { float* rowp = C + (size_t)(row0 + ai * HALF + m * 16) * ldc + col0;
#pragma unroll
                for (int bj = 0; bj < 2; ++bj)
#pragma unroll
                    for (int n = 0; n < 2; ++n) *(f32x4*)(rowp + bj * HALF + n * 16) = acc[ai][bj][m][n]; }
    }
};
struct EpiRes {
    static constexpr bool PERM = false, AFTER_DRAIN = false;
    bf16_t* C; const float* R; int ldc;
    __device__ __forceinline__ void operator()(const f32x4 (&acc)[2][2][4][2], const Unit& u, int wr, int wc, int fr, int fq) const {
        const int row0 = u.pm * BM + wr * 64 + fr, col0 = u.pn * BM + wc * 32 + 4 * fq;
#pragma unroll
        for (int ai = 0; ai < 2; ++ai)
#pragma unroll
            for (int m = 0; m < 4; ++m) { const size_t off = (size_t)(row0 + ai * HALF + m * 16) * ldc + col0;
#pragma unroll
                for (int bj = 0; bj < 2; ++bj)
#pragma unroll
                    for (int n = 0; n < 2; ++n) { const f32x4 v = *(const f32x4*)(R + off + bj * HALF + n * 16) + acc[ai][bj][m][n];
                        u32x2p o; o.x = cvt_pk_bf16(v[0], v[1]); o.y = cvt_pk_bf16(v[2], v[3]);
                        *(u32x2p*)(C + off + bj * HALF + n * 16) = o; } }
    }
};

struct EpiSwiGLU {
    static constexpr bool PERM = true, AFTER_DRAIN = false;
    bf16_t* HID;
    __device__ __forceinline__ void operator()(const f32x4 (&acc)[2][2][4][2], const Unit& u, int wr, int wc, int fr, int fq) const {
        const int row0 = u.pm * BM + wr * 64 + fr, col0 = (u.pn & 7) * 128 + wc * 32 + 8 * fq;
#pragma unroll
        for (int ai = 0; ai < 2; ++ai)
#pragma unroll
            for (int m = 0; m < 4; ++m) { bf16_t* rowp = HID + (size_t)(row0 + ai * HALF + m * 16) * 1024 + col0;
                float h[8];
#pragma unroll
                for (int n = 0; n < 2; ++n)
#pragma unroll
                    for (int i = 0; i < 4; ++i) { const float gv = acc[ai][0][m][n][i], uv = acc[ai][1][m][n][i]; h[n * 4 + i] = gv * __builtin_amdgcn_rcpf(1.f + __expf(-gv)) * uv; }
                u32x4 w; w.x = cvt_pk_bf16(h[0], h[1]); w.y = cvt_pk_bf16(h[2], h[3]); w.z = cvt_pk_bf16(h[4], h[5]); w.w = cvt_pk_bf16(h[6], h[7]);
                *(u32x4*)rowp = w; }
    }
};
struct EpiMoeOut {
    static constexpr bool PERM = true, AFTER_DRAIN = false;
    bf16_t* Y2; const int* tsi; const float* wrow; const PG8_LAS int* offs; const PG8_LAS int* cnts;
    __device__ __forceinline__ void operator()(const f32x4 (&acc)[2][2][4][2], const Unit& u, int wr, int wc, int fr, int fq) const {
        const int e = u.pn >> 3, lim = offs[e] + cnts[e], lb = e * 16384 - offs[e];
        const int row0 = u.pm * BM + wr * 64 + fr, col0 = (u.pn & 7) * BM + wc * 32 + 8 * fq;
#pragma unroll
        for (int ai = 0; ai < 2; ++ai)
#pragma unroll
            for (int m = 0; m < 4; ++m) { const int p = row0 + ai * HALF + m * 16;
                if (p < lim) { const float w = wrow[lb + p]; bf16_t* rowp = Y2 + (size_t)tsi[lb + p] * 2048 + col0;
#pragma unroll
                    for (int bj = 0; bj < 2; ++bj) { const f32x4 v0 = acc[ai][bj][m][0] * w, v1 = acc[ai][bj][m][1] * w;
                        u32x4 o; o.x = cvt_pk_bf16(v0[0], v0[1]); o.y = cvt_pk_bf16(v0[2], v0[3]); o.z = cvt_pk_bf16(v1[0], v1[1]); o.w = cvt_pk_bf16(v1[2], v1[3]);
                        *(u32x4*)(rowp + bj * HALF) = o; } } }
    }
};
struct GroupedOrder {
    const PG8_LAS int* rt_exp; int nunits, G, c;
    int nmain, tail, ways;
    __device__ __forceinline__ void init(const PG8_LAS int* rt_exp_, int nunits_, int G_, int c_) {
        rt_exp = rt_exp_; nunits = nunits_; G = G_; c = c_;
        const int r = nunits - ((nunits + G - 1) / G - 1) * G;
        tail = 0; ways = 1;
        if (r * 4 <= G) { tail = r; ways = 4; } else if (r * 2 <= G) { tail = r; ways = 2; }
#if MOE_TAIL_TEST
        tail = MOE_TAIL_TEST < nunits ? MOE_TAIL_TEST : nunits; ways = MOE_TAIL_WAYS;
#endif
        nmain = nunits - tail; }
    __device__ __forceinline__ bool next(int i, Unit& u) const {
        const int nm = c < nmain ? (nmain - c + G - 1) / G : 0;
        int L; u.sub = -1;
        if (i < nm) L = i * G + c;
        else if (i == nm && tail > 0 && c / ways < tail) { L = nmain + c / ways; u.sub = ways == 4 ? (c & 3) : 4 + (c & 1); }
        else return false;
        const int rt = L >> 3; u.pm = rt; u.pn = rt_exp[rt] * 8 + (L & 7); return true; }
    __device__ __forceinline__ void a_ready(const Unit&) const {}
    __device__ __forceinline__ void done(const Unit&) const {}
};

struct EpiProj {
    static constexpr bool PERM = true, AFTER_DRAIN = false;
    bf16_t *QH, *VH, *GH, *QN, *KV6; bf16_t* LOGF; float* GATE; const float* LB;
    __device__ __forceinline__ static u32x4 pack8(const f32x4 a, const f32x4 b) { u32x4 w; w.x = cvt_pk_bf16(a[0], a[1]); w.y = cvt_pk_bf16(a[2], a[3]); w.z = cvt_pk_bf16(b[0], b[1]); w.w = cvt_pk_bf16(b[2], b[3]); return w; }
    __device__ __forceinline__ static f32x4 silu4(const f32x4 v) { f32x4 o; for (int i = 0; i < 4; ++i) o[i] = v[i] * __builtin_amdgcn_rcpf(1.f + __expf(-v[i])); return o; }
    __device__ __forceinline__ void operator()(const f32x4 (&acc)[2][2][4][2], const Unit& u, int wr, int wc, int fr, int fq) const {
        const int pn = u.pn, row0 = u.pm * BM + wr * 64 + fr, cl = wc * 32 + 8 * fq;
#pragma unroll
        for (int ai = 0; ai < 2; ++ai)
#pragma unroll
            for (int m = 0; m < 4; ++m) { const size_t row = (size_t)(row0 + ai * HALF + m * 16);
#pragma unroll
                for (int bj = 0; bj < 2; ++bj) { const int c256 = bj * HALF + cl; f32x4 v0 = acc[ai][bj][m][0], v1 = acc[ai][bj][m][1];
                    if (pn < 4) { *(u32x4*)(QH + row * 1024 + pn * 256 + c256) = pack8(silu4(v0), silu4(v1)); }
                    else if (pn < 8) { const int col = (pn - 4) * 256 + c256; const f32x4 l0 = *(const f32x4*)(LB + col), l1 = *(const f32x4*)(LB + col + 4); f32x4 o0, o1;
                        for (int i = 0; i < 4; ++i) { o0[i] = __logf(l0[i] + (1.f - l0[i]) * __builtin_amdgcn_rcpf(1.f + __expf(-v0[i]))); o1[i] = __logf(l1[i] + (1.f - l1[i]) * __builtin_amdgcn_rcpf(1.f + __expf(-v1[i]))); }
                        *(u32x4*)(LOGF + row * 1024 + col) = pack8(o0, o1); }
                    else if (pn < 12) { *(u32x4*)(VH + row * 1024 + (pn - 8) * 256 + c256) = pack8(v0, v1); }
                    else if (pn < 16) { *(u32x4*)(GH + row * 1024 + (pn - 12) * 256 + c256) = pack8(silu4(v0), silu4(v1)); }
                    else if (pn < 20) { const float sc = 0.125f * 1.4426950408889634f; *(u32x4*)(QN + row * 1024 + (pn - 16) * 256 + c256) = pack8(v0 * sc, v1 * sc); }
                    else if (pn < 26) { *(u32x4*)(KV6 + (size_t)(pn - 20) * ((size_t)16384 * 256) + row * 256 + c256) = pack8(v0, v1); }
                    else if (c256 < 64) { f32x4 o0, o1; for (int i = 0; i < 4; ++i) { o0[i] = __builtin_amdgcn_rcpf(1.f + __expf(-v0[i])); o1[i] = __builtin_amdgcn_rcpf(1.f + __expf(-v1[i])); }
                        *(f32x4*)(GATE + row * 64 + c256) = o0; *(f32x4*)(GATE + row * 64 + c256 + 4) = o1; } } }
    }
};
template <class Epi, class Sched, bool ALIGN_EPI = false, bool SP2 = false>
__device__ __forceinline__ void gemm_phase(PG8_LAS unsigned char* lds, const Gemm g, const Sched& S, const Epi& E, int wave_in) {
    const int wid = __builtin_amdgcn_readfirstlane(wave_in), lane = lane_id(), tid = wid * 64 + lane, wr = wid >> 2, wc = wid & 3, fr = lane & 15, fq = lane >> 4;
    const int K = g.K, nt = K / BK;
    unsigned voffA[2], voffB[2];
#pragma unroll
    for (int i = 0; i < 2; ++i) { int R, C; stage_rc(tid * 16 + i * 8192, R, C); const int Rb = Epi::PERM ? ((R & ~31) + perm32(R & 31)) : R;
        voffA[i] = (unsigned)(R * K + C) * 2u; voffB[i] = (unsigned)(Rb * K + C) * 2u; }
    const size_t kstep = (size_t)(BK * 2);
    const size_t hstep = (size_t)HALF * K * 2;
    const size_t tstep = 2 * hstep;
    const unsigned ldsw = (unsigned)wid * 1024u;
    const int aoff = lds_byte(wr * 64 + fr, fq * 8), boff = lds_byte(wc * 32 + fr, fq * 8);
#define PG8_SA(b, h) (((b) * 2 + (h)) * HTB)
#define PG8_SB(b, h) ((4 + (b) * 2 + (h)) * HTB)
#define PG8_STAGE(bufoff, gbase, voff) do { _Pragma("unroll") for (int _i = 0; _i < 2; ++_i) \
        __builtin_amdgcn_global_load_lds((const unsigned*)((const char*)(gbase) + (voff)[_i]), (PG8_LAS unsigned*)(lds + (bufoff) + ldsw + _i * 8192), 16, 0, 0); } while (0)
#define PG8_LDA(dst, b, h) do { _Pragma("unroll") for (int m = 0; m < 4; ++m) _Pragma("unroll") for (int k = 0; k < 2; ++k) dst[m][k] = *(const PG8_LAS bf16x8*)(lds + PG8_SA(b, h) + aoff + m * 2048 + k * 1024); } while (0)
#define PG8_LDB(dst, b, h) do { _Pragma("unroll") for (int n = 0; n < 2; ++n) _Pragma("unroll") for (int k = 0; k < 2; ++k) dst[n][k] = *(const PG8_LAS bf16x8*)(lds + PG8_SB(b, h) + boff + n * 2048 + k * 1024); } while (0)
#define PG8_MMA(ai, bj, At, Bt) do { __builtin_amdgcn_s_setprio(1); _Pragma("unroll") for (int m = 0; m < 4; ++m) _Pragma("unroll") for (int n = 0; n < 2; ++n) _Pragma("unroll") for (int k = 0; k < 2; ++k) \
        acc[ai][bj][m][n] = __builtin_amdgcn_mfma_f32_16x16x32_bf16(Bt[n][k], At[m][k], acc[ai][bj][m][n], 0, 0, 0); __builtin_amdgcn_s_setprio(0); } while (0)
#define PG8_WAIT_V(n) asm volatile("s_waitcnt vmcnt(" #n ")" ::: "memory")
#define PG8_WAIT_L(n) asm volatile("s_waitcnt lgkmcnt(" #n ")" ::: "memory")
#define PG8_BAR __builtin_amdgcn_s_barrier()
#define PG8_SCHED __builtin_amdgcn_sched_barrier(0)
    Unit cur, nxt; int ui = 0;
    if (!S.next(0, cur)) return;
    f32x4 acc[2][2][4][2];
#pragma unroll
    for (int a = 0; a < 2; ++a)
#pragma unroll
        for (int b = 0; b < 2; ++b)
#pragma unroll
            for (int m = 0; m < 4; ++m)
#pragma unroll
                for (int n = 0; n < 2; ++n) acc[a][b][m][n] = (f32x4){0.f, 0.f, 0.f, 0.f};
    bf16x8 At[4][2], B0[2][2], B1[2][2];
    const char* cA = (const char*)g.A + (size_t)cur.pm * tstep; const char* cB = (const char*)g.Bt + (size_t)cur.pn * tstep;
    S.a_ready(cur);
    if constexpr (SP2) {
        PG8_STAGE(PG8_SB(0, 0), cB, voffB); PG8_STAGE(PG8_SB(0, 1), cB + hstep, voffB); PG8_STAGE(PG8_SA(0, 0), cA, voffA); PG8_STAGE(PG8_SA(0, 1), cA + hstep, voffA);
        if (wr == 1) PG8_BAR;
        PG8_WAIT_V(2); PG8_BAR;
        PG8_STAGE(PG8_SB(1, 0), cB + kstep, voffB); PG8_STAGE(PG8_SA(1, 0), cA + kstep, voffA); PG8_STAGE(PG8_SB(1, 1), cB + hstep + kstep, voffB);
        PG8_WAIT_V(6); PG8_BAR;
    } else {
        PG8_STAGE(PG8_SB(0, 0), cB, voffB); PG8_STAGE(PG8_SA(0, 0), cA, voffA); PG8_STAGE(PG8_SB(0, 1), cB + hstep, voffB); PG8_STAGE(PG8_SA(0, 1), cA + hstep, voffA);
        if (wr == 1) PG8_BAR;
        PG8_WAIT_V(4); PG8_BAR;
        PG8_STAGE(PG8_SB(1, 0), cB + kstep, voffB); PG8_STAGE(PG8_SA(1, 0), cA + kstep, voffA); PG8_STAGE(PG8_SB(1, 1), cB + hstep + kstep, voffB);
        PG8_WAIT_V(6); PG8_BAR;
    }
    for (;;) {
        const bool has_next = S.next(ui + 1, nxt);
        const char* nA = has_next ? (const char*)g.A + (size_t)nxt.pm * tstep : cA; const char* nB = has_next ? (const char*)g.Bt + (size_t)nxt.pn * tstep : cB;
        for (int t = 0; t < nt; t += 2) {
            const bool last = (t == nt - 2);
            const char* a1 = cA + (size_t)(t + 1) * kstep;
            const char* a2 = last ? nA : cA + (size_t)(t + 2) * kstep; const char* b2 = last ? nB : cB + (size_t)(t + 2) * kstep;
            const char* a3 = a2 + kstep; const char* b3 = b2 + kstep;
            if (last && has_next) S.a_ready(nxt);
            if constexpr (SP2) {
            PG8_LDB(B0, 0, 0); PG8_LDB(B1, 0, 1); PG8_SCHED; PG8_LDA(At, 0, 0); PG8_STAGE(PG8_SA(1, 1), a1 + hstep, voffA);
            PG8_WAIT_V(8); PG8_WAIT_L(0); PG8_BAR; PG8_MMA(0, 0, At, B0); PG8_MMA(0, 1, At, B1); PG8_BAR; PG8_SCHED;
            PG8_LDA(At, 0, 1); PG8_STAGE(PG8_SB(0, 0), b2, voffB); PG8_STAGE(PG8_SB(0, 1), b2 + hstep, voffB); PG8_STAGE(PG8_SA(0, 0), a2, voffA);
            PG8_WAIT_V(8); PG8_WAIT_L(0); PG8_BAR; PG8_MMA(1, 0, At, B0); PG8_MMA(1, 1, At, B1); PG8_BAR; PG8_SCHED;
            PG8_LDB(B0, 1, 0); PG8_LDB(B1, 1, 1); PG8_SCHED; PG8_LDA(At, 1, 0); PG8_STAGE(PG8_SA(0, 1), a2 + hstep, voffA);
            PG8_WAIT_V(8); PG8_WAIT_L(0); PG8_BAR; PG8_MMA(0, 0, At, B0); PG8_MMA(0, 1, At, B1); PG8_BAR; PG8_SCHED;
            PG8_LDA(At, 1, 1); PG8_STAGE(PG8_SB(1, 0), b3, voffB); PG8_STAGE(PG8_SB(1, 1), b3 + hstep, voffB); PG8_STAGE(PG8_SA(1, 0), a3, voffA);
            PG8_WAIT_V(8); PG8_WAIT_L(0); PG8_BAR; PG8_MMA(1, 0, At, B0); PG8_MMA(1, 1, At, B1); PG8_BAR; PG8_SCHED;
            } else {
            PG8_LDB(B0, 0, 0); PG8_SCHED; PG8_LDA(At, 0, 0); PG8_STAGE(PG8_SA(1, 1), a1 + hstep, voffA);
            PG8_WAIT_L(8); PG8_BAR; PG8_WAIT_L(0); PG8_MMA(0, 0, At, B0); PG8_BAR; PG8_SCHED;
            PG8_LDB(B1, 0, 1); PG8_STAGE(PG8_SB(0, 0), b2, voffB);
            PG8_BAR; PG8_WAIT_L(0); PG8_MMA(0, 1, At, B1); PG8_BAR;
            PG8_LDA(At, 0, 1); PG8_STAGE(PG8_SA(0, 0), a2, voffA);
            PG8_BAR; PG8_WAIT_L(0); PG8_MMA(1, 0, At, B0); PG8_BAR; PG8_SCHED;
            PG8_STAGE(PG8_SB(0, 1), b2 + hstep, voffB);
            PG8_WAIT_V(6); PG8_BAR; PG8_MMA(1, 1, At, B1); PG8_BAR;
            PG8_LDB(B0, 1, 0); PG8_SCHED; PG8_LDA(At, 1, 0); PG8_STAGE(PG8_SA(0, 1), a2 + hstep, voffA);
            PG8_WAIT_L(8); PG8_BAR; PG8_WAIT_L(0); PG8_MMA(0, 0, At, B0); PG8_BAR; PG8_SCHED;
            PG8_LDB(B1, 1, 1); PG8_STAGE(PG8_SB(1, 0), b3, voffB);
            PG8_BAR; PG8_WAIT_L(0); PG8_MMA(0, 1, At, B1); PG8_BAR;
            PG8_LDA(At, 1, 1); PG8_STAGE(PG8_SA(1, 0), a3, voffA);
            PG8_BAR; PG8_WAIT_L(0); PG8_MMA(1, 0, At, B0); PG8_BAR; PG8_SCHED;
            PG8_STAGE(PG8_SB(1, 1), b3 + hstep, voffB);
            PG8_WAIT_V(6); PG8_BAR; PG8_MMA(1, 1, At, B1); PG8_BAR;
            }
        }
        if constexpr (ALIGN_EPI) { if (wr == 0) PG8_BAR; }
        if constexpr (!Epi::AFTER_DRAIN) { E(acc, cur, wr, wc, fr, fq); S.done(cur); }
        if (!has_next) break;
#pragma unroll
        for (int a = 0; a < 2; ++a)
#pragma unroll
            for (int b = 0; b < 2; ++b)
#pragma unroll
                for (int m = 0; m < 4; ++m)
#pragma unroll
                    for (int n = 0; n < 2; ++n) acc[a][b][m][n] = (f32x4){0.f, 0.f, 0.f, 0.f};
        cur = nxt; cA = nA; cB = nB; ++ui;
        if constexpr (ALIGN_EPI) { if (wr == 1) PG8_BAR; }
    }
    PG8_WAIT_V(0);
    if constexpr (!ALIGN_EPI) { if (wr == 0) PG8_BAR; }
    PG8_BAR;
    if constexpr (Epi::AFTER_DRAIN) { E.fused(acc, cur, wr, wc, fr, fq, lds, wid, lane); S.done(cur); }
#undef PG8_SA
#undef PG8_SB
#undef PG8_STAGE
#undef PG8_LDA
#undef PG8_LDB
#undef PG8_MMA
#undef PG8_WAIT_V
#undef PG8_WAIT_L
#undef PG8_BAR
#undef PG8_SCHED
}

template <class Epi, bool G1>
__device__ __forceinline__ void moe_gemm(PG8_LAS unsigned char* lds, const bf16_t* Abase, const int* tsi, const float* W0, const float* W1, const PG8_LAS int* offs, const PG8_LAS int* cnts,
                                         const GroupedOrder& S, const Epi& E, int wave_in) {
    constexpr int K = G1 ? 2048 : 1024, NT = K / BK, LDW = G1 ? 1024 : 2048;
    const int wid = __builtin_amdgcn_readfirstlane(wave_in), lane = lane_id(), tid = wid * 64 + lane, wr = wid >> 2, wc = wid & 3, fr = lane & 15, fq = lane >> 4;
    int RA[2], CA[2];
#pragma unroll
    for (int i = 0; i < 2; ++i) stage_rc(tid * 16 + i * 8192, RA[i], CA[i]);
    const unsigned ldsw = (unsigned)wid * 1024u;
    const int aoff = lds_byte(wr * 64 + fr, fq * 8), boff = lds_byte(wc * 32 + fr, fq * 8);
    const int hfB = wid >> 2, kgB = (tid >> 5) & 7, ngB = tid & 31, g8 = ngB & 7;
    const int wB0 = lds_byte(32 * (ngB >> 3) + (g8 & 1) * 16 + (g8 >> 1) * 4, 8 * kgB);
#define MG_WACT(u) ((u).sub < 0 || ((u).sub < 4 ? wc == (u).sub : (wc >> 1) == (u).sub - 4))
#define MG_BACT(u) ((u).sub < 0 || ((u).sub < 4 ? (ngB >> 3) == (u).sub : (ngB >> 4) == (u).sub - 4))
#define MG_SA(b, h) (((b) * 2 + (h)) * HTB)
#define MG_SB(b, h) ((4 + (b) * 2 + (h)) * HTB)
#define MG_ROWS(u, dst) do { const int e_ = (u).pn >> 3, lim_ = offs[e_] + cnts[e_]; _Pragma("unroll") for (int h_ = 0; h_ < 2; ++h_) _Pragma("unroll") for (int i_ = 0; i_ < 2; ++i_) { \
        const int p_ = (u).pm * 256 + h_ * 128 + RA[i_]; const int row_ = G1 ? ((p_ < lim_ ? tsi[e_ * 16384 + p_ - offs[e_]] : 0) >> 1) : p_; dst[h_][i_] = p_ < lim_ ? (unsigned)row_ * (unsigned)(K * 2) + (unsigned)(CA[i_] * 2) : 0xffffffffu; } } while (0)
#define MG_BPTR(u) (G1 ? ((hfB ? W1 : W0) + (size_t)((u).pn >> 3) * 2048 * 1024 + 128 * ((u).pn & 7) + 4 * ngB + (size_t)(8 * kgB) * LDW) \
                       : (W0 + (size_t)((u).pn >> 3) * 1024 * 2048 + 256 * ((u).pn & 7) + 128 * hfB + 4 * ngB + (size_t)(8 * kgB) * LDW))
#define MG_STAGE_A(b, rows, k0) do { _Pragma("unroll") for (int h_ = 0; h_ < 2; ++h_) _Pragma("unroll") for (int i_ = 0; i_ < 2; ++i_) if (rows[h_][i_] != 0xffffffffu) \
        __builtin_amdgcn_global_load_lds((const unsigned*)((const char*)Abase + rows[h_][i_] + (k0) * 2), (PG8_LAS unsigned*)(lds + MG_SA(b, h_) + ldsw + i_ * 8192), 16, 0, 0); } while (0)
#define MG_LOAD_B(ptr, k0) do { _Pragma("unroll") for (int j_ = 0; j_ < 8; ++j_) bv[j_] = *(const f32x4*)((ptr) + (size_t)((k0) + j_) * LDW); } while (0)
#define MG_WRITE_B(b) do { _Pragma("unroll") for (int c_ = 0; c_ < 4; ++c_) { u32x4 w_; w_.x = cvt_pk_bf16(bv[0][c_], bv[1][c_]); w_.y = cvt_pk_bf16(bv[2][c_], bv[3][c_]); w_.z = cvt_pk_bf16(bv[4][c_], bv[5][c_]); w_.w = cvt_pk_bf16(bv[6][c_], bv[7][c_]); \
        *(PG8_LAS u32x4*)(lds + MG_SB(b, hfB) + wB0 + 64 * c_) = w_; } } while (0)
#define MG_LDA(dst, b, h, mp) do { _Pragma("unroll") for (int m = 0; m < 2; ++m) _Pragma("unroll") for (int k = 0; k < 2; ++k) dst[m][k] = *(const PG8_LAS bf16x8*)(lds + MG_SA(b, h) + aoff + (2 * (mp) + m) * 2048 + k * 1024); } while (0)
#define MG_LDB(dst, b, h) do { _Pragma("unroll") for (int n = 0; n < 2; ++n) _Pragma("unroll") for (int k = 0; k < 2; ++k) dst[n][k] = *(const PG8_LAS bf16x8*)(lds + MG_SB(b, h) + boff + n * 2048 + k * 1024); } while (0)
#define MG_MMA(ai, bj, mp, At, Bt) do { __builtin_amdgcn_s_setprio(1); _Pragma("unroll") for (int m = 0; m < 2; ++m) _Pragma("unroll") for (int n = 0; n < 2; ++n) _Pragma("unroll") for (int k = 0; k < 2; ++k) \
        acc[ai][bj][2 * (mp) + m][n] = __builtin_amdgcn_mfma_f32_16x16x32_bf16(Bt[n][k], At[m][k], acc[ai][bj][2 * (mp) + m][n], 0, 0, 0); __builtin_amdgcn_s_setprio(0); } while (0)
#define MG_SYNC() do { asm volatile("s_waitcnt vmcnt(0) lgkmcnt(0)" ::: "memory"); __builtin_amdgcn_s_barrier(); asm volatile("" ::: "memory"); } while (0)
    Unit cur, nxt; int ui = 0;
    if (!S.next(0, cur)) return;
    f32x4 acc[2][2][4][2];
#pragma unroll
    for (int a = 0; a < 2; ++a)
#pragma unroll
        for (int b = 0; b < 2; ++b)
#pragma unroll
            for (int m = 0; m < 4; ++m)
#pragma unroll
                for (int n = 0; n < 2; ++n) acc[a][b][m][n] = (f32x4){0.f, 0.f, 0.f, 0.f};
    bf16x8 At[2][2], B0[2][2], B1[2][2];
    f32x4 bv[8];
    unsigned rowC[2][2];
    MG_ROWS(cur, rowC); const float* bC = MG_BPTR(cur); bool bact = MG_BACT(cur);
    MG_STAGE_A(0, rowC, 0); if (bact) { MG_LOAD_B(bC, 0); MG_WRITE_B(0); }
    MG_SYNC();
    int buf = 0;
    for (;;) {
        const bool has_next = S.next(ui + 1, nxt);
        const bool wact = MG_WACT(cur);
        for (int t = 0; t < NT; ++t) {
            const bool last = (t == NT - 1), more = !last || has_next;
            if (!last) { if (bact) MG_LOAD_B(bC, (t + 1) * BK); MG_STAGE_A(buf ^ 1, rowC, (t + 1) * BK); }
            else if (has_next) { bC = MG_BPTR(nxt); bact = MG_BACT(nxt); if (bact) MG_LOAD_B(bC, 0); MG_ROWS(nxt, rowC); MG_STAGE_A(buf ^ 1, rowC, 0); }
            if (wact) { MG_LDB(B0, buf, 0); MG_LDB(B1, buf, 1);
#pragma unroll
              for (int ai = 0; ai < 2; ++ai)
#pragma unroll
                for (int mp = 0; mp < 2; ++mp) { MG_LDA(At, buf, ai, mp); MG_MMA(ai, 0, mp, At, B0); MG_MMA(ai, 1, mp, At, B1); } }
            if (more && bact) MG_WRITE_B(buf ^ 1);
            MG_SYNC();
            buf ^= 1;
        }
        if (wact) E(acc, cur, wr, wc, fr, fq);
        if (!has_next) break;
#pragma unroll
        for (int a = 0; a < 2; ++a)
#pragma unroll
            for (int b = 0; b < 2; ++b)
#pragma unroll
                for (int m = 0; m < 4; ++m)
#pragma unroll
                    for (int n = 0; n < 2; ++n) acc[a][b][m][n] = (f32x4){0.f, 0.f, 0.f, 0.f};
        cur = nxt; ++ui;
    }
#undef MG_SA
#undef MG_WACT
#undef MG_BACT
#undef MG_SB
#undef MG_ROWS
#undef MG_BPTR
#undef MG_STAGE_A
#undef MG_LOAD_B
#undef MG_WRITE_B
#undef MG_LDA
#undef MG_LDB
#undef MG_MMA
#undef MG_SYNC
}
}

__device__ __forceinline__ float wave_sum(float v) {
#pragma unroll
    for (int o = 32; o >= 1; o >>= 1) v += __shfl_xor(v, o);
    return v;
}
__device__ __forceinline__ float wave_max(float v) {
#pragma unroll
    for (int o = 32; o >= 1; o >>= 1) v = fmaxf(v, __shfl_xor(v, o));
    return v;
}
__device__ __forceinline__ unsigned f2bf(float f) { unsigned u = __builtin_bit_cast(unsigned, f); return (u + 0x7fffu + ((u >> 16) & 1u)) >> 16; }
__device__ __forceinline__ unsigned pk2(float lo, float hi) { return f2bf(lo) | (f2bf(hi) << 16); }
typedef unsigned short bf16;
typedef unsigned u32x4 __attribute__((ext_vector_type(4)));
typedef unsigned u32x2 __attribute__((ext_vector_type(2)));
__device__ __forceinline__ float bf_lo(unsigned u) { return __builtin_bit_cast(float, u << 16); }
__device__ __forceinline__ float bf_hi(unsigned u) { return __builtin_bit_cast(float, u & 0xffff0000u); }
__device__ __forceinline__ float sigm(float x) { return 1.f / (1.f + expf(-x)); }
__device__ __forceinline__ float silu(float x) { return x / (1.f + expf(-x)); }
__device__ __forceinline__ int rel_bucket(int n) {
    if (n < 16) return n < 0 ? 0 : n;
    if (n >= 113) return 31;
    if (n <= 18) return 16; if (n <= 20) return 17; if (n <= 23) return 18; if (n <= 26) return 19; if (n <= 30) return 20; if (n <= 34) return 21;
    if (n <= 39) return 22; if (n <= 45) return 23; if (n <= 51) return 24; if (n <= 58) return 25; if (n <= 66) return 26; if (n <= 76) return 27;
    if (n <= 86) return 28; if (n <= 98) return 29; return 30;
}

struct Frame {
    LAS unsigned char* lds; int tid, lane, wave, gw, NGW, gtid, NT;
    const float *i_x, *i_norm1_g, *i_w_in, *i_lbl, *i_hg_norm_g, *i_pe_k, *i_w1_k, *i_w2_k, *i_pe_v, *i_w1_v, *i_w2_v, *i_rel_bias, *i_w_out, *i_norm2_g, *i_wrg, *i_brg, *i_wre, *i_bre, *i_weg, *i_weu, *i_wed, *i_final_g; float* out; unsigned char* ws;
    template <class Tp> __device__ __forceinline__ Tp* w(size_t off) const { return (Tp*)(ws + off); }
};

#define CAS __attribute__((address_space(4)))
__device__ __forceinline__ Frame relocal(int wave) {
    const CAS Args* ap = (const CAS Args*)__builtin_amdgcn_kernarg_segment_ptr();
    asm volatile("" : "+s"(ap)); asm volatile("" : "+s"(wave));
    Frame F; extern __shared__ __attribute__((aligned(16))) unsigned char lds_raw[];
    F.lds = (LAS unsigned char*)lds_raw;
    const int ln = (int)__builtin_amdgcn_mbcnt_hi(~0u, __builtin_amdgcn_mbcnt_lo(~0u, 0u));
    F.wave = wave; F.lane = ln; F.tid = wave * 64 + ln;
    F.gw = blockIdx.x * 8 + wave; F.NGW = gridDim.x * 8; F.gtid = blockIdx.x * NTHR + F.tid; F.NT = gridDim.x * NTHR;
    F.i_x = ap->in[0]; F.i_norm1_g = ap->in[1]; F.i_w_in = ap->in[2]; F.i_lbl = ap->in[3]; F.i_hg_norm_g = ap->in[4]; F.i_pe_k = ap->in[5]; F.i_w1_k = ap->in[6]; F.i_w2_k = ap->in[7]; F.i_pe_v = ap->in[8]; F.i_w1_v = ap->in[9]; F.i_w2_v = ap->in[10]; F.i_rel_bias = ap->in[11]; F.i_w_out = ap->in[12]; F.i_norm2_g = ap->in[13]; F.i_wrg = ap->in[14]; F.i_brg = ap->in[15]; F.i_wre = ap->in[16]; F.i_bre = ap->in[17]; F.i_weg = ap->in[18]; F.i_weu = ap->in[19]; F.i_wed = ap->in[20]; F.i_final_g = ap->in[21];
    F.out = ap->out; F.ws = ap->ws;
    return F;
}
__device__ __forceinline__ void transpose_item(const float* W, int K, int ldw, int nvalid, int k0, int n0, bf16* WT, int drow0, LAS float* scr, int lane, bool frag = false) {
    const int rsub = lane >> 3, c4 = lane & 7; const bool ok = n0 + 4 * c4 < nvalid;
    f32x4 v[8];
#pragma unroll
    for (int i = 0; i < 8; ++i) v[i] = ok ? __builtin_nontemporal_load((const f32x4*)(W + (size_t)(k0 + 8 * i + rsub) * ldw + n0 + 4 * c4)) : (f32x4){0.f, 0.f, 0.f, 0.f};
#pragma unroll
    for (int i = 0; i < 8; ++i) { LAS float* d = scr + (8 * i + rsub) * 33 + 4 * c4; d[0] = v[i][0]; d[1] = v[i][1]; d[2] = v[i][2]; d[3] = v[i][3]; }
    asm volatile("s_waitcnt lgkmcnt(0)" ::: "memory");
    const int c = lane & 7;
#pragma unroll
    for (int j = 0; j < 4; ++j) { const int n = (lane >> 3) + 8 * j; const LAS float* sp = scr + (8 * c) * 33 + n;
        u32x4 o; o.x = pk2(sp[0 * 33], sp[1 * 33]); o.y = pk2(sp[2 * 33], sp[3 * 33]); o.z = pk2(sp[4 * 33], sp[5 * 33]); o.w = pk2(sp[6 * 33], sp[7 * 33]);
        const int kk = k0 + 8 * c, nr = drow0 + n;
        bf16* dst = frag ? WT + ((size_t)(((nr >> 5) * (K >> 4) + (kk >> 4)) * 64 + ((kk >> 3) & 1) * 32 + (nr & 31))) * 8 : WT + (size_t)nr * K + kk;
        __builtin_nontemporal_store(o, (u32x4*)dst); }
    asm volatile("s_waitcnt lgkmcnt(0)" ::: "memory");
}
__device__ __forceinline__ void ph_prologue(const Frame& F) {
    const float* x = F.i_x; const float* g1 = F.i_norm1_g; bf16* HB = F.w<bf16>(WS_HB);
    { f32x4 v[8], vn[8];
      int m = F.gw;
      if (m < T) { const f32x4* xr = (const f32x4*)(x + (size_t)m * D);
#pragma unroll
          for (int j = 0; j < 8; ++j) v[j] = __builtin_nontemporal_load(xr + F.lane + 64 * j); }
      for (; m < T; m += F.NGW) {
          const int mn = m + F.NGW;
          if (mn < T) { const f32x4* xn = (const f32x4*)(x + (size_t)mn * D);
#pragma unroll
              for (int j = 0; j < 8; ++j) vn[j] = __builtin_nontemporal_load(xn + F.lane + 64 * j); }
          float ss = 0.f;
#pragma unroll
          for (int j = 0; j < 8; ++j) ss += v[j].x * v[j].x + v[j].y * v[j].y + v[j].z * v[j].z + v[j].w * v[j].w;
          const float r = rsqrtf(wave_sum(ss) * (1.f / D) + EPS);
          u32x2* hr = (u32x2*)(HB + (size_t)m * D);
#pragma unroll
          for (int j = 0; j < 8; ++j) { const float4 g = ((const float4*)g1)[F.lane + 64 * j]; u32x2 o; o.x = pk2(v[j].x * r * g.x, v[j].y * r * g.y); o.y = pk2(v[j].z * r * g.z, v[j].w * r * g.w); hr[F.lane + 64 * j] = o; }
#pragma unroll
          for (int j = 0; j < 8; ++j) v[j] = vn[j];
      } }
    const float* lbl = F.i_lbl; float* LB = F.w<float>(WS_LB);
    for (int i = F.gtid; i < 1024; i += F.NT) { const float l0 = lbl[i], l1 = lbl[1024 + i], m = fmaxf(l0, l1), e0 = expf(l0 - m), e1 = expf(l1 - m); LB[i] = e0 / (e0 + e1); }
    const float* wrg = F.i_wrg; const float* brg = F.i_brg; const float* wre = F.i_wre; const float* bre = F.i_bre;
    bf16* WRT = F.w<bf16>(WS_WRT); float* BR = F.w<float>(WS_BR);
    for (int i = F.gtid; i < 96 * 2048; i += F.NT) { const int n = i >> 11, k = i & 2047; WRT[i] = (bf16)f2bf(n < 8 ? wrg[k * 8 + n] : (n < 72 ? wre[k * 64 + (n - 8)] : 0.f)); }
    for (int c = F.gtid; c < 128; c += F.NT) BR[c] = c < 8 ? brg[c] : (c < 72 ? bre[c - 8] : 0.f);
    LAS float* scr = (LAS float*)(F.lds + F.wave * 16384);
    constexpr int I_IN = (D / 64) * (LDP / 32), I_OUT = (D / 64) * (D / 32), I_W1 = 32 * 8, I_W2 = 4 * 2;
    for (int it = F.gw; it < I_IN + I_OUT + 2 * I_W1 + 2 * I_W2; it += F.NGW) {
        if (it < I_IN) { const int kb = it / (LDP / 32), nb = it % (LDP / 32); transpose_item(F.i_w_in, D, WIN_N, WIN_N, 64 * kb, 32 * nb, F.w<bf16>(WS_WINT), 32 * nb, scr, F.lane); }
        else if (it < I_IN + I_OUT) { const int r = it - I_IN, kb = r / (D / 32), nb = r % (D / 32); transpose_item(F.i_w_out, D, D, D, 64 * kb, 32 * nb, F.w<bf16>(WS_WOUTT), 32 * nb, scr, F.lane); }
        else if (it < I_IN + I_OUT + 2 * I_W1) { const int r = it - I_IN - I_OUT, which = r / I_W1, q = r % I_W1, kb = q >> 3, nb = q & 7;
            transpose_item(which ? F.i_w1_v : F.i_w1_k, 2048, 256, 256, 64 * kb, 32 * nb, F.w<bf16>(WS_W1T) + (size_t)which * 256 * 2048, 32 * nb, scr, F.lane, true); }
        else { const int r = it - I_IN - I_OUT - 2 * I_W1, which = r / I_W2, q = r % I_W2, kb = q >> 1, nb = q & 1;
            transpose_item(which ? F.i_w2_v : F.i_w2_k, 256, 64, 64, 64 * kb, 32 * nb, F.w<bf16>(WS_W2T) + (size_t)which * 64 * 256, 32 * nb, scr, F.lane); }
    }
}

__device__ __forceinline__ void ph_inproj(const Frame& F) {
    pg8::Gemm g{F.w<bf16>(WS_HB), F.w<bf16>(WS_WINT), T, LDP, D}; pg8::StaticOrder So; So.init(T, LDP, (int)gridDim.x, (int)blockIdx.x);
    pg8::EpiProj E{F.w<bf16>(WS_QH), F.w<bf16>(WS_VH), F.w<bf16>(WS_GH), F.w<bf16>(WS_QN), F.w<bf16>(WS_KV6), F.w<bf16>(WS_LOGF), F.w<float>(WS_GATE), F.w<float>(WS_LB)};
    pg8::gemm_phase<pg8::EpiProj, pg8::StaticOrder, true, true>(F.lds, g, So, E, F.wave);
}

namespace nsa {
typedef float f32x16 __attribute__((ext_vector_type(16)));
typedef short s16x8 __attribute__((ext_vector_type(8)));
typedef short s16x4 __attribute__((ext_vector_type(4)));
typedef float f32x2v __attribute__((ext_vector_type(2)));
typedef __bf16 bf16x2v __attribute__((ext_vector_type(2)));
#define NSA_MFMA(a, b, c) __builtin_amdgcn_mfma_f32_32x32x16_bf16((a), (b), (c), 0, 0, 0)
#define NDI __device__ __forceinline__
constexpr int KP = 144, VP = 144, VCP = 528;
constexpr int L_KS = 0, L_VT = 18432, L_KC = 0, L_VCT = 36864, L_BIAS = 70656, L_STAT = 74752, L_IMPA = 76800, L_IMPB = 93184, L_SEL = 109568;
constexpr float NEG = -1e30f, LOG2E = 1.4426950408889634f;

NDI unsigned pkbf(float a, float b) { return __builtin_bit_cast(unsigned, __builtin_convertvector(((f32x2v){a, b}), bf16x2v)); }
NDI float hmax32(float v) { auto rr = __builtin_amdgcn_permlane32_swap(__float_as_uint(v), __float_as_uint(v), false, false); return fmaxf(__uint_as_float(rr[0]), __uint_as_float(rr[1])); }
NDI float hsum32(float v) { auto rr = __builtin_amdgcn_permlane32_swap(__float_as_uint(v), __float_as_uint(v), false, false); return __uint_as_float(rr[0]) + __uint_as_float(rr[1]); }

NDI void st_block(f32x16 (&Sv)[2], const LAS char* ks, const s16x8 (&Qf)[4], int r, int h) {
    f32x16 a0, a1;
#pragma unroll
    for (int i = 0; i < 16; ++i) { a0[i] = 0.f; a1[i] = 0.f; }
    s16x8 k0[4], k1[4];
#pragma unroll
    for (int s = 0; s < 4; ++s) { k0[s] = *(const LAS s16x8*)(ks + r * KP + 32 * s + 16 * h); k1[s] = *(const LAS s16x8*)(ks + (32 + r) * KP + 32 * s + 16 * h); }
#pragma unroll
    for (int s = 0; s < 4; ++s) { a0 = NSA_MFMA(k0[s], Qf[s], a0); a1 = NSA_MFMA(k1[s], Qf[s], a1); }
    Sv[0] = a0; Sv[1] = a1;
}
NDI void pv_block(const f32x16 (&P)[2], f32x16 (&O)[2], const LAS char* vt, int pitch, int r, int h) {
#pragma unroll
    for (int t = 0; t < 2; ++t)
#pragma unroll
        for (int sp = 0; sp < 2; ++sp) {
            u32x4 w; w.x = pkbf(P[t][8 * sp + 0], P[t][8 * sp + 1]); w.y = pkbf(P[t][8 * sp + 2], P[t][8 * sp + 3]); w.z = pkbf(P[t][8 * sp + 4], P[t][8 * sp + 5]); w.w = pkbf(P[t][8 * sp + 6], P[t][8 * sp + 7]);
            const s16x8 pf = __builtin_bit_cast(s16x8, w);
#pragma unroll
            for (int dt = 0; dt < 2; ++dt) { const LAS char* a = vt + (32 * dt + r) * pitch + (32 * t + 16 * sp + 4 * h) * 2;
                const s16x4 lo = *(const LAS s16x4*)a, hi = *(const LAS s16x4*)(a + 16);
                const s16x8 af = __builtin_shufflevector(lo, hi, 0, 1, 2, 3, 4, 5, 6, 7);
                O[dt] = NSA_MFMA(af, pf, O[dt]); } }
}
template <int MASK, int BIAS>
NDI void bias_mask(f32x16 (&Sv)[2], const LAS float* btab, int bj0, int lim) {
#pragma unroll
    for (int t = 0; t < 2; ++t) {
        float bb[16];
        if (BIAS != 0) {
#pragma unroll
            for (int i = 0; i < 16; ++i) { const int kc = 32 * t + (i & 3) + 8 * (i >> 2);
                if (BIAS == 1) bb[i] = btab[kc]; else { int j = bj0 + 16 * kc; j = j < 0 ? 0 : (j > 255 ? 255 : j); bb[i] = btab[j]; } }
            asm volatile("s_waitcnt lgkmcnt(0)" ::: "memory"); }
#pragma unroll
        for (int i = 0; i < 16; ++i) { const int kc = 32 * t + (i & 3) + 8 * (i >> 2);
            float s = Sv[t][i];
            if (BIAS != 0) s += bb[i];
            if (MASK == 1) s = (kc <= lim) ? s : NEG; else if (MASK == 2) s = (kc > lim) ? s : NEG; else if (MASK == 3) s = (kc < lim) ? s : NEG;
            Sv[t][i] = s; } }
}
NDI void softmax_core(f32x16 (&Sv)[2], float& m, float& lsum, f32x16 (&O)[2], bool rowactive) {
    float bm = NEG;
#pragma unroll
    for (int t = 0; t < 2; ++t)
#pragma unroll
        for (int i = 0; i < 16; ++i) bm = fmaxf(bm, Sv[t][i]);
    bm = hmax32(bm); if (!rowactive) bm = NEG;
    const float mn = fmaxf(m, bm), alpha = __builtin_amdgcn_exp2f(m - mn), msel = (rowactive && mn > -1e29f) ? mn : 1e30f; m = mn;
    float ps = 0.f;
#pragma unroll
    for (int t = 0; t < 2; ++t)
#pragma unroll
        for (int i = 0; i < 16; ++i) { const float p = __builtin_amdgcn_exp2f(Sv[t][i] - msel); Sv[t][i] = p; ps += p; }
    lsum = lsum * alpha + ps;
    if (__builtin_amdgcn_ballot_w64(alpha != 1.f) != 0ull) {
#pragma unroll
        for (int dt = 0; dt < 2; ++dt)
#pragma unroll
            for (int i = 0; i < 16; ++i) O[dt][i] *= alpha; }
}
#define NSA_MX3(a, b, c) __builtin_fmaxf(__builtin_fmaxf((a), (b)), (c))
NDI float rowmax2(const f32x16& p0, const f32x16& p1) {
    float a = NSA_MX3(p0[0], p0[1], p1[0]), b = NSA_MX3(p0[2], p0[3], p1[1]); a = NSA_MX3(a, p1[2], p1[3]);
#pragma unroll
    for (int r = 4; r < 16; r += 4) { a = NSA_MX3(a, p0[r], p0[r + 1]); b = NSA_MX3(b, p0[r + 2], p0[r + 3]); a = NSA_MX3(a, p1[r], p1[r + 1]); b = NSA_MX3(b, p1[r + 2], p1[r + 3]); }
    return hmax32(__builtin_fmaxf(a, b)); }
NDI void st_block_c(f32x16 (&Sv)[2], const LAS char* ks, const s16x8 (&Qf)[4], int r, int h, const f32x16& cinit) {
    f32x16 a0, a1; s16x8 k0[4], k1[4];
#pragma unroll
    for (int s = 0; s < 4; ++s) { k0[s] = *(const LAS s16x8*)(ks + r * KP + 32 * s + 16 * h); k1[s] = *(const LAS s16x8*)(ks + (32 + r) * KP + 32 * s + 16 * h); }
    a0 = NSA_MFMA(k0[0], Qf[0], cinit); a1 = NSA_MFMA(k1[0], Qf[0], cinit);
#pragma unroll
    for (int s = 1; s < 4; ++s) { a0 = NSA_MFMA(k0[s], Qf[s], a0); a1 = NSA_MFMA(k1[s], Qf[s], a1); }
    Sv[0] = a0; Sv[1] = a1;
}
NDI void softmax_lazy(f32x16 (&Sv)[2], f32x16& cinit, float& mhat, float& lsum, f32x16 (&O)[2], bool act, bool first) {
    float rm = rowmax2(Sv[0], Sv[1]); if (!act) rm = NEG;
    bool mv = first; float dlt = rm;
    if (!first) { mv = __builtin_amdgcn_ballot_w64(rm > 8.f) != 0ull; dlt = __builtin_fmaxf(rm, 0.f); }
    if (mv) {
        if (!first) { const float f = __builtin_amdgcn_exp2f(-dlt); lsum *= f;
#pragma unroll
            for (int dt = 0; dt < 2; ++dt)
#pragma unroll
                for (int i = 0; i < 16; ++i) O[dt][i] *= f; }
        mhat += dlt; const float nm = -mhat;
#pragma unroll
        for (int i = 0; i < 16; ++i) { Sv[0][i] -= dlt; Sv[1][i] -= dlt; cinit[i] = nm; } }
    float ps = 0.f;
#pragma unroll
    for (int t = 0; t < 2; ++t)
#pragma unroll
        for (int i = 0; i < 16; ++i) { const float p = __builtin_amdgcn_exp2f(Sv[t][i]); Sv[t][i] = p; ps += p; }
    lsum += act ? ps : 0.f;
}
typedef short v4i16_t __attribute__((ext_vector_type(4)));
NDI s16x4 vtr(const LAS char* p) { return __builtin_bit_cast(s16x4, __builtin_amdgcn_ds_read_tr16_b64_v4i16((LAS v4i16_t*)p)); }
NDI void pv_block_m(const f32x16 (&P)[2], f32x16 (&O)[2], const LAS char* vimg, int lane, unsigned am) {
    const LAS char* vp = vimg + ((lane >> 4) & 1) * 32 + (lane & 3) * 8 + (4 * (lane >> 5) + ((lane & 15) >> 2)) * 64;
#pragma unroll
    for (int t = 0; t < 2; ++t)
#pragma unroll
        for (int sp = 0; sp < 2; ++sp) {
            u32x4 w; w.x = pkbf(P[t][8 * sp + 0], P[t][8 * sp + 1]) & am; w.y = pkbf(P[t][8 * sp + 2], P[t][8 * sp + 3]) & am; w.z = pkbf(P[t][8 * sp + 4], P[t][8 * sp + 5]) & am; w.w = pkbf(P[t][8 * sp + 6], P[t][8 * sp + 7]) & am;
            const s16x8 pf = __builtin_bit_cast(s16x8, w);
#pragma unroll
            for (int dt = 0; dt < 2; ++dt) { const LAS char* a = vp + dt * 4096 + (2 * t + sp) * 1024;
                const s16x4 lo = vtr(a), hi = vtr(a + 512);
                const s16x8 af = __builtin_shufflevector(lo, hi, 0, 1, 2, 3, 4, 5, 6, 7);
                O[dt] = NSA_MFMA(af, pf, O[dt]); } }
}
NDI void zero2(f32x16 (&X)[2]) {
#pragma unroll
    for (int dt = 0; dt < 2; ++dt)
#pragma unroll
        for (int i = 0; i < 16; ++i) X[dt][i] = 0.f;
}
NDI void finish_branch(unsigned (&OUTP)[2][8], const f32x16 (&O)[2], float lsum, float gate, bool first) {
    const float lt = hsum32(lsum), sc = lt > 0.f ? gate / lt : 0.f;
#pragma unroll
    for (int dt = 0; dt < 2; ++dt)
#pragma unroll
        for (int i = 0; i < 8; ++i) { const float a = first ? 0.f : bf_lo(OUTP[dt][i]), bq = first ? 0.f : bf_hi(OUTP[dt][i]); OUTP[dt][i] = pkbf(a + O[dt][2 * i] * sc, bq + O[dt][2 * i + 1] * sc); }
}

struct Ptrs { const bf16* QN; const bf16* KV6; const float* GATE; const bf16* KC; const bf16* VC; const float* relb; bf16* MIXB; };

NDI void blk_load(const bf16* kbase, const bf16* vbase, size_t row0, int g, int tid, u32x4& kreg, u32x4& vreg) {
    kreg = *(const u32x4*)(kbase + (row0 + (tid >> 3)) * 256 + g * 64 + (tid & 7) * 8);
    vreg = *(const u32x4*)(vbase + (row0 + (tid >> 3)) * 256 + g * 64 + (tid & 7) * 8);
}
NDI void blk_store(LAS char* L, int buf, int tid, const u32x4& kreg, const u32x4& vreg) {
    *(LAS u32x4*)(L + L_KS + buf * 9216 + (tid >> 3) * KP + (tid & 7) * 16) = kreg;
    *(LAS u32x4*)(L + L_VT + buf * 9216 + ((tid >> 2) & 1) * 4096 + (tid >> 3) * 64 + (tid & 3) * 16) = vreg;
}

NDI void attn_unit(const Ptrs& P, LAS char* L, int tid, int w, int b, int g, int c) {
    asm volatile("" : "+v"(tid)); asm volatile("" : "+s"(w));
    const int lane = tid & 63, r = lane & 31, h = lane >> 5, hh = w >> 1, tl = 32 * (w & 1) + r, tq = 64 * c + tl;
    const size_t tok0 = (size_t)b * S + 64 * c;
    LAS float* biasTab = (LAS float*)(L + L_BIAS); LAS float* stat = (LAS float*)(L + L_STAT);
    LAS float* impA = (LAS float*)(L + L_IMPA); LAS float* impB = (LAS float*)(L + L_IMPB); LAS unsigned* selw = (LAS unsigned*)(L + L_SEL);
    __syncthreads();
    { const int row = tid >> 1, half = tid & 1; const bool ok = row < NCMP;
      const u32x4* ks = (const u32x4*)(P.KC + ((size_t)(b * 4 + g) * NCMP + (ok ? row : 0)) * 64 + 32 * half);
      const u32x4* vs = (const u32x4*)(P.VC + ((size_t)(b * 4 + g) * NCMP + (ok ? row : 0)) * 64 + 32 * half);
#pragma unroll
      for (int q = 0; q < 4; ++q) { u32x4 a = ks[q]; if (!ok) a = (u32x4){0u, 0u, 0u, 0u}; *(LAS u32x4*)(L + L_KC + row * KP + (32 * half + 8 * q) * 2) = a; }
#pragma unroll
      for (int q = 0; q < 4; ++q) { u32x4 a = vs[q]; if (!ok) a = (u32x4){0u, 0u, 0u, 0u};
          *(LAS u32x4*)(L + L_VCT + (row >> 6) * 8192 + half * 4096 + (row & 63) * 64 + q * 16) = a; }
    }
    for (int i = tid; i < 1024; i += NTHR) { const int dist = 191 - (i & 255), hq = g * 4 + (i >> 8); biasTab[i] = LOG2E * (P.relb[rel_bucket(dist) * 16 + hq] - P.relb[31 * 16 + hq]); }
    constexpr int L_QS = 110592, QSP = 528;
    { const int tk = tid >> 3; const bf16* qsrc = P.QN + (tok0 + tk) * 1024 + g * 256;
#pragma unroll
      for (int j = 0; j < 4; ++j) { const int pc = (tid & 7) + 8 * j; *(LAS u32x4*)(L + L_QS + tk * QSP + pc * 16) = *(const u32x4*)(qsrc + 8 * pc); } }
    const float bc31 = 0.f;
    const float* gl = P.GATE + (tok0 + tl) * 64 + g * 4 + hh;
    const float g0 = gl[0], g1 = gl[16], g2 = gl[32];
    __syncthreads();
    s16x8 Qf[4];
#pragma unroll
    for (int s = 0; s < 4; ++s) Qf[s] = *(const LAS s16x8*)(L + L_QS + tl * QSP + hh * 128 + 32 * s + 16 * h);
    const int nv = tq >= 31 ? (tq - 31) / 16 + 1 : 0;
    const int nvmax = (64 * c + 63 - 31) / 16 + 1;
    f32x16 O[2], Sv[2]; zero2(O); unsigned OUTP[2][8];
    float m = NEG, lsum = 0.f;
    const LAS float* btab_h = biasTab + hh * 256;
#pragma unroll 1
    for (int kb = 0; 64 * kb < nvmax; ++kb) {
        st_block(Sv, L + L_KC + 64 * kb * KP, Qf, r, h);
        if (64 * c - (16 * (64 * kb + 63) + 31) < 113) bias_mask<3, 2>(Sv, btab_h, 222 - tq + 16 * (64 * kb + 4 * h), nv - 64 * kb - 4 * h);
        softmax_core(Sv, m, lsum, O, true);
        pv_block_m(Sv, O, L + L_VCT + kb * 8192, lane, 0xffffffffu);
    }
    { const float lt = hsum32(lsum); if (h == 0) { stat[(hh * 64 + tl) * 2] = m; stat[(hh * 64 + tl) * 2 + 1] = lt > 0.f ? 1.f / lt : 0.f; } }
    finish_branch(OUTP, O, lsum, g0, true);
    __syncthreads();
    { const int kq = w >> 1; f32x16 PS[2]; zero2(PS);
      if (64 * kq < nvmax) {
#pragma unroll 1
          for (int hq = 0; hq < 4; ++hq) { s16x8 Q2[4];
#pragma unroll
              for (int s = 0; s < 4; ++s) Q2[s] = *(const LAS s16x8*)(L + L_QS + tl * QSP + hq * 128 + 32 * s + 16 * h);
              f32x16 S2[2]; st_block(S2, L + L_KC + 64 * kq * KP, Q2, r, h);
              const float mm = stat[(hq * 64 + tl) * 2], iv = stat[(hq * 64 + tl) * 2 + 1]; const LAS float* bt = biasTab + hq * 256;
              const int bj0 = 222 - tq + 16 * (64 * kq + 4 * h), lim = nv - 64 * kq - 4 * h;
#pragma unroll
              for (int t = 0; t < 2; ++t)
#pragma unroll
                  for (int i = 0; i < 16; ++i) { const int kc = 32 * t + (i & 3) + 8 * (i >> 2); int j = bj0 + 16 * kc; j = j < 0 ? 0 : (j > 255 ? 255 : j);
                      const float pe = __builtin_amdgcn_exp2f(S2[t][i] + bt[j] - mm) * iv; PS[t][i] += (kc < lim) ? pe : 0.f; } } }
#pragma unroll
      for (int t = 0; t < 2; ++t)
#pragma unroll
          for (int q4 = 0; q4 < 4; ++q4) { const int g4 = 16 * kq + 8 * t + 2 * q4 + h;
              impA[tl * 64 + g4] = (PS[t][4 * q4] + PS[t][4 * q4 + 1]) + (PS[t][4 * q4 + 2] + PS[t][4 * q4 + 3]);
              if (g4 < 63) impB[tl * 64 + g4 + 1] = PS[t][4 * q4 + 3]; }
      if (kq == 0 && h == 0) impB[tl * 64] = 0.f; }
    __syncthreads();
    {
      unsigned key[8], thr[8];
#pragma unroll
      for (int tt = 0; tt < 8; ++tt) { const int tok = 8 * w + tt;
          const float imp = impA[tok * 64 + lane] + impB[tok * 64 + lane];
          const float val = (lane == 0 || lane == c || lane == c - 1) ? 1e9f : (lane > c ? -1e9f : imp);
          const unsigned u = __float_as_uint(val); key[tt] = (u & 0x80000000u) ? ~u : (u | 0x80000000u); thr[tt] = 0u; }
#pragma unroll 1
      for (int bit = 31; bit >= 0; --bit) {
#pragma unroll
          for (int tt = 0; tt < 8; ++tt) { const unsigned cand = thr[tt] | (1u << bit);
              if (__builtin_popcountll(__builtin_amdgcn_ballot_w64(key[tt] >= cand)) >= 16) thr[tt] = cand; } }
#pragma unroll
      for (int tt = 0; tt < 8; ++tt) { const int tok = 8 * w + tt;
          const unsigned long long gt = __builtin_amdgcn_ballot_w64(key[tt] > thr[tt]), eq = __builtin_amdgcn_ballot_w64(key[tt] == thr[tt]);
          const int need = 16 - __builtin_popcountll(gt);
          const bool sel = key[tt] > thr[tt] || (key[tt] == thr[tt] && __builtin_popcountll(eq & ((1ull << lane) - 1ull)) < need);
          const unsigned long long mk = __builtin_amdgcn_ballot_w64(sel && lane <= c);
          if (lane == 0) { selw[2 * tok] = (unsigned)mk; selw[2 * tok + 1] = (unsigned)(mk >> 32); } } }
    __syncthreads();
    unsigned ulo = selw[2 * lane], uhi = selw[2 * lane + 1];
#pragma unroll
    for (int o = 32; o >= 1; o >>= 1) { ulo |= __shfl_xor(ulo, o); uhi |= __shfl_xor(uhi, o); }
    const unsigned long long um = (unsigned long long)__builtin_amdgcn_readfirstlane(ulo) | ((unsigned long long)__builtin_amdgcn_readfirstlane(uhi) << 32);
    __syncthreads();
    const bf16* Ksl = P.KV6 + (size_t)2 * T * 256; const bf16* Vsl = P.KV6 + (size_t)3 * T * 256; const bf16* Kwn = P.KV6 + (size_t)4 * T * 256; const bf16* Vwn = P.KV6 + (size_t)5 * T * 256;
    u32x4 kreg, vreg; f32x16 cinit;
    { unsigned long long rem = um & ~(1ull << c);
      int cur = c, n = 0; zero2(O); m = 0.f; lsum = 0.f;
#pragma unroll
      for (int i = 0; i < 16; ++i) cinit[i] = 0.f;
      blk_load(Ksl, Vsl, (size_t)b * S + 64 * cur, g, tid, kreg, vreg); blk_store(L, 0, tid, kreg, vreg);
      __syncthreads();
      while (cur >= 0) {
          const int nxt = rem ? 63 - __builtin_clzll(rem) : -1; if (nxt >= 0) rem &= ~(1ull << nxt);
          if (nxt >= 0) blk_load(Ksl, Vsl, (size_t)b * S + 64 * nxt, g, tid, kreg, vreg);
          const int buf = n & 1, dl = c - cur; const bool act = (selw[2 * tl + (cur >> 5)] >> (cur & 31)) & 1u;
          st_block_c(Sv, L + L_KS + buf * 9216, Qf, r, h, cinit);
          if (dl == 0) bias_mask<1, 1>(Sv, btab_h + (191 - tl + 4 * h), 0, tl - 4 * h);
          else if (dl <= 2) bias_mask<0, 1>(Sv, btab_h + (191 - 64 * dl - tl + 4 * h), 0, 0);
          softmax_lazy(Sv, cinit, m, lsum, O, act, n == 0);
          pv_block_m(Sv, O, L + L_VT + buf * 9216, lane, act ? 0xffffffffu : 0u);
          if (nxt >= 0) blk_store(L, buf ^ 1, tid, kreg, vreg);
          __syncthreads();
          cur = nxt; ++n; }
      finish_branch(OUTP, O, lsum, g1, false); }
    { int cur = c, n = 0; const int last = c >= 8 ? c - 8 : 0; zero2(O); m = 0.f; lsum = 0.f;
#pragma unroll
      for (int i = 0; i < 16; ++i) cinit[i] = 0.f;
      blk_load(Kwn, Vwn, (size_t)b * S + 64 * cur, g, tid, kreg, vreg); blk_store(L, 0, tid, kreg, vreg);
      __syncthreads();
      while (cur >= last) {
          const int nxt = cur - 1; const bool more = nxt >= last;
          if (more) blk_load(Kwn, Vwn, (size_t)b * S + 64 * nxt, g, tid, kreg, vreg);
          const int buf = n & 1, dl = c - cur;
          st_block_c(Sv, L + L_KS + buf * 9216, Qf, r, h, cinit);
          if (dl == 0) bias_mask<1, 1>(Sv, btab_h + (191 - tl + 4 * h), 0, tl - 4 * h);
          else if (dl <= 2) bias_mask<0, 1>(Sv, btab_h + (191 - 64 * dl - tl + 4 * h), 0, 0);
          else if (dl == 8) bias_mask<2, 0>(Sv, btab_h, 0, tl - 4 * h);
          softmax_lazy(Sv, cinit, m, lsum, O, true, n == 0);
          pv_block_m(Sv, O, L + L_VT + buf * 9216, lane, 0xffffffffu);
          if (more) blk_store(L, buf ^ 1, tid, kreg, vreg);
          __syncthreads();
          cur = nxt; ++n; }
      finish_branch(OUTP, O, lsum, g2, false); }
    { int tl2 = tl; asm volatile("" : "+v"(tl2));
      bf16* orow = P.MIXB + (tok0 + tl2) * 2048 + 1024 + (g * 4 + hh) * 64;
#pragma unroll
      for (int dt = 0; dt < 2; ++dt)
#pragma unroll
          for (int q4 = 0; q4 < 4; ++q4) { u32x2 o; o.x = OUTP[dt][2 * q4]; o.y = OUTP[dt][2 * q4 + 1];
              *(u32x2*)(orow + 32 * dt + 8 * q4 + 4 * h) = o; } }
}
#undef NSA_MFMA
#undef NSA_MX3
#undef NDI
}

namespace hg {
typedef float f32x16 __attribute__((ext_vector_type(16)));
typedef short s16x8 __attribute__((ext_vector_type(8)));
typedef short s16x4 __attribute__((ext_vector_type(4)));
typedef float f32x2e __attribute__((ext_vector_type(2)));
#define HG_MFMA(a, b, c) __builtin_amdgcn_mfma_f32_32x32x16_bf16((a), (b), (c), 0, 0, 0)
#define HDI __device__ __forceinline__
constexpr int QP = 272, HP = 144, SP = 272;
constexpr int L_QT = 0, L_KT = 17408, L_KHT = 34816, L_VT = 53248, L_ST = 71680, L_BL = 106496, L_PART = 107008;
struct Ptrs { const bf16* QH; const bf16* LOGF; const bf16* VH; const bf16* GH; const float* ng; bf16* MIXB; float* SLOC; float* LSUM; };

template <bool PASS2>
HDI void item(const Ptrs& P, LAS char* L, int tid, int w, int it) {
    asm volatile("" : "+v"(tid)); asm volatile("" : "+s"(w));
    const int lane = tid & 63, r = lane & 31, h = lane >> 5;
    const int b = it >> 6, hd = (it >> 3) & 7, seg = it & 7;
    if (!PASS2 && seg == 7) return;
    LAS float* bl = (LAS float*)(L + L_BL); LAS float* part = (LAS float*)(L + L_PART);
    const int dkt = w >> 1, dvp = w & 1;
    f32x16 ST[2];
#pragma unroll
    for (int j = 0; j < 2; ++j)
#pragma unroll
        for (int i = 0; i < 16; ++i) ST[j][i] = 0.f;
    __syncthreads();
    if (PASS2) {
        float lsv[16], slv[2][16];
        if (seg > 0) { const int pit = (it & ~7); const float* ls = P.LSUM + (size_t)pit * 128; const float* sl = P.SLOC + (size_t)pit * 16384;
#pragma unroll
            for (int i = 0; i < 16; ++i) { const int dk = 32 * dkt + 8 * (i >> 2) + 4 * h + (i & 3); lsv[i] = ls[dk];
#pragma unroll
                for (int j = 0; j < 2; ++j) slv[j][i] = sl[dk * 128 + 32 * (2 * dvp + j) + r]; } }
        for (int sj = 0; sj < seg; ++sj) {
            float lsc[16], slc[2][16];
#pragma unroll
            for (int i = 0; i < 16; ++i) { lsc[i] = lsv[i]; slc[0][i] = slv[0][i]; slc[1][i] = slv[1][i]; }
            if (sj + 1 < seg) { const int pit = (it & ~7) + sj + 1; const float* ls = P.LSUM + (size_t)pit * 128; const float* sl = P.SLOC + (size_t)pit * 16384;
#pragma unroll
                for (int i = 0; i < 16; ++i) { const int dk = 32 * dkt + 8 * (i >> 2) + 4 * h + (i & 3); lsv[i] = ls[dk];
#pragma unroll
                    for (int j = 0; j < 2; ++j) slv[j][i] = sl[dk * 128 + 32 * (2 * dvp + j) + r]; } }
#pragma unroll
            for (int j = 0; j < 2; ++j)
#pragma unroll
                for (int i = 0; i < 16; ++i) ST[j][i] = __expf(lsc[i]) * ST[j][i] + slc[j][i]; }
#pragma unroll
        for (int j = 0; j < 2; ++j)
#pragma unroll
            for (int q4 = 0; q4 < 4; ++q4) { u32x2 o; o.x = nsa::pkbf(ST[j][4 * q4], ST[j][4 * q4 + 1]); o.y = nsa::pkbf(ST[j][4 * q4 + 2], ST[j][4 * q4 + 3]);
                *(LAS u32x2*)(L + L_ST + (32 * (2 * dvp + j) + r) * SP + (32 * dkt + 8 * q4 + 4 * h) * 2) = o; }
    }
    float lsum_d[2] = {0.f, 0.f};
    const size_t rowbase = (size_t)b * S + seg * 512;
    const int d2 = tid & 63, tq8 = tid >> 6;
    unsigned lf2[8], qv2[8], vv2[8];
    { const size_t o0 = (rowbase + 8 * tq8) * 1024 + hd * 128 + 2 * d2;
#pragma unroll
      for (int i = 0; i < 8; ++i) { lf2[i] = *(const unsigned*)(P.LOGF + o0 + (size_t)i * 1024); vv2[i] = *(const unsigned*)(P.VH + o0 + (size_t)i * 1024); if (PASS2) qv2[i] = *(const unsigned*)(P.QH + o0 + (size_t)i * 1024); } }
    for (int ck = 0; ck < 8; ++ck) {
        const size_t row0 = rowbase + ck * 64;
        float cs[2][8]; float run[2] = {0.f, 0.f};
#pragma unroll
        for (int i = 0; i < 8; ++i) { run[0] += bf_lo(lf2[i]); cs[0][i] = run[0]; run[1] += bf_hi(lf2[i]); cs[1][i] = run[1]; }
        *(LAS f32x2e*)(part + tq8 * 128 + 2 * d2) = (f32x2e){run[0], run[1]};
        __syncthreads();
        float off[2] = {0.f, 0.f}, tot[2] = {0.f, 0.f};
#pragma unroll
        for (int j = 0; j < 8; ++j) { const f32x2e pj = *(const LAS f32x2e*)(part + j * 128 + 2 * d2); tot[0] += pj[0]; tot[1] += pj[1]; off[0] += (j < tq8) ? pj[0] : 0.f; off[1] += (j < tq8) ? pj[1] : 0.f; }
        if (tq8 == 0) { bl[2 * d2] = __expf(tot[0]); bl[2 * d2 + 1] = __expf(tot[1]); lsum_d[0] += tot[0]; lsum_d[1] += tot[1]; }
        float khv[2][8];
#pragma unroll
        for (int i = 0; i < 8; ++i) { float qt[2], kt[2];
#pragma unroll
            for (int e = 0; e < 2; ++e) { const float lfe = e ? bf_hi(lf2[i]) : bf_lo(lf2[i]), bb = off[e] + cs[e][i], f = __expf(lfe), k = 1.f - f;
                khv[e][i] = k * __expf(tot[e] - bb);
                if (PASS2) { qt[e] = (e ? bf_hi(qv2[i]) : bf_lo(qv2[i])) * __expf(bb); kt[e] = k * __expf(-bb); } }
            if (PASS2) { const int t = 8 * tq8 + i;
                *(LAS unsigned*)(L + L_QT + t * QP + 4 * d2) = nsa::pkbf(qt[0], qt[1]);
                *(LAS unsigned*)(L + L_KT + t * QP + 4 * d2) = nsa::pkbf(kt[0], kt[1]); } }
#pragma unroll
        for (int e = 0; e < 2; ++e) { const int d = 2 * d2 + e;
            u32x4 a; a.x = nsa::pkbf(khv[e][0], khv[e][1]); a.y = nsa::pkbf(khv[e][2], khv[e][3]); a.z = nsa::pkbf(khv[e][4], khv[e][5]); a.w = nsa::pkbf(khv[e][6], khv[e][7]);
            *(LAS u32x4*)(L + L_KHT + d * HP + 16 * tq8) = a;
            u32x4 v;
            if (e == 0) { v.x = (vv2[0] & 0xffffu) | (vv2[1] << 16); v.y = (vv2[2] & 0xffffu) | (vv2[3] << 16); v.z = (vv2[4] & 0xffffu) | (vv2[5] << 16); v.w = (vv2[6] & 0xffffu) | (vv2[7] << 16); }
            else        { v.x = (vv2[0] >> 16) | (vv2[1] & 0xffff0000u); v.y = (vv2[2] >> 16) | (vv2[3] & 0xffff0000u); v.z = (vv2[4] >> 16) | (vv2[5] & 0xffff0000u); v.w = (vv2[6] >> 16) | (vv2[7] & 0xffff0000u); }
            *(LAS u32x4*)(L + L_VT + d * HP + 16 * tq8) = v; }
        if (ck < 7) { const size_t o0 = (row0 + 64 + 8 * tq8) * 1024 + hd * 128 + 2 * d2;
#pragma unroll
            for (int i = 0; i < 8; ++i) { lf2[i] = *(const unsigned*)(P.LOGF + o0 + (size_t)i * 1024); vv2[i] = *(const unsigned*)(P.VH + o0 + (size_t)i * 1024); if (PASS2) qv2[i] = *(const unsigned*)(P.QH + o0 + (size_t)i * 1024); } }
        __syncthreads();
        if (PASS2) { const int dvt = w >> 1, tt = w & 1;
            u32x2 gbv[4];
            { const size_t base = (row0 + 32 * tt + r) * 1024 + hd * 128 + 32 * dvt + 4 * h;
#pragma unroll
              for (int q4 = 0; q4 < 4; ++q4) gbv[q4] = *(const u32x2*)(P.GH + base + 8 * q4); }
            f32x16 O;
#pragma unroll
            for (int i = 0; i < 16; ++i) O[i] = 0.f;
#pragma unroll
            for (int st = 0; st < 2; ++st) if (st <= tt) { f32x16 acc;
#pragma unroll
                for (int i = 0; i < 16; ++i) acc[i] = 0.f;
#pragma unroll
                for (int ks = 0; ks < 8; ++ks) { const s16x8 a = *(const LAS s16x8*)(L + L_KT + (32 * st + r) * QP + 32 * ks + 16 * h), bq = *(const LAS s16x8*)(L + L_QT + (32 * tt + r) * QP + 32 * ks + 16 * h); acc = HG_MFMA(a, bq, acc); }
                if (st == tt) {
#pragma unroll
                    for (int i = 0; i < 16; ++i) acc[i] = ((i & 3) + 8 * (i >> 2) + 4 * h <= r) ? acc[i] : 0.f; }
#pragma unroll
                for (int sp = 0; sp < 2; ++sp) { u32x4 pw; pw.x = nsa::pkbf(acc[8 * sp + 0], acc[8 * sp + 1]); pw.y = nsa::pkbf(acc[8 * sp + 2], acc[8 * sp + 3]); pw.z = nsa::pkbf(acc[8 * sp + 4], acc[8 * sp + 5]); pw.w = nsa::pkbf(acc[8 * sp + 6], acc[8 * sp + 7]);
                    const s16x8 pf = __builtin_bit_cast(s16x8, pw);
                    const LAS char* ap = L + L_VT + (32 * dvt + r) * HP + (32 * st + 16 * sp + 4 * h) * 2;
                    const s16x4 lo = *(const LAS s16x4*)ap, hi = *(const LAS s16x4*)(ap + 16);
                    O = HG_MFMA(__builtin_shufflevector(lo, hi, 0, 1, 2, 3, 4, 5, 6, 7), pf, O); } }
#pragma unroll
            for (int ks = 0; ks < 8; ++ks) { const s16x8 a = *(const LAS s16x8*)(L + L_ST + (32 * dvt + r) * SP + 32 * ks + 16 * h), bq = *(const LAS s16x8*)(L + L_QT + (32 * tt + r) * QP + 32 * ks + 16 * h); O = HG_MFMA(a, bq, O); }
            LAS float* ssq = (LAS float*)(L + L_PART + 4096);
            { float q2 = 0.f;
#pragma unroll
              for (int i = 0; i < 16; ++i) q2 += O[i] * O[i];
              q2 = nsa::hsum32(q2); if (h == 0) ssq[dvt * 64 + 32 * tt + r] = q2; }
            __syncthreads();
            { const int tloc = 32 * tt + r; const float tot = (ssq[tloc] + ssq[64 + tloc]) + (ssq[128 + tloc] + ssq[192 + tloc]);
              const float rs = rsqrtf(tot * (1.f / 128.f) + EPS);
              const size_t base = (row0 + tloc) * 1024 + hd * 128 + 32 * dvt + 4 * h;
#pragma unroll
              for (int q4 = 0; q4 < 4; ++q4) { const u32x2 gb = gbv[q4]; const f32x4 nv = *(const f32x4*)(P.ng + 32 * dvt + 4 * h + 8 * q4);
                  u32x2 ov; ov.x = nsa::pkbf(O[4 * q4] * rs * nv[0] * bf_lo(gb.x), O[4 * q4 + 1] * rs * nv[1] * bf_hi(gb.x)); ov.y = nsa::pkbf(O[4 * q4 + 2] * rs * nv[2] * bf_lo(gb.y), O[4 * q4 + 3] * rs * nv[3] * bf_hi(gb.y));
                  *(u32x2*)(P.MIXB + (row0 + tloc) * 2048 + hd * 128 + 32 * dvt + 4 * h + 8 * q4) = ov; } }
        }
#pragma unroll
        for (int j = 0; j < 2; ++j) { f32x16 acc = ST[j];
#pragma unroll
            for (int i = 0; i < 16; ++i) acc[i] *= bl[32 * dkt + 8 * (i >> 2) + 4 * h + (i & 3)];
#pragma unroll
            for (int ks = 0; ks < 4; ++ks) { const s16x8 a = *(const LAS s16x8*)(L + L_KHT + (32 * dkt + r) * HP + 32 * ks + 16 * h), bv = *(const LAS s16x8*)(L + L_VT + (32 * (2 * dvp + j) + r) * HP + 32 * ks + 16 * h); acc = HG_MFMA(a, bv, acc); }
            ST[j] = acc; }
        if (PASS2) {
            __syncthreads();
#pragma unroll
            for (int j = 0; j < 2; ++j)
#pragma unroll
                for (int q4 = 0; q4 < 4; ++q4) { u32x2 o; o.x = nsa::pkbf(ST[j][4 * q4], ST[j][4 * q4 + 1]); o.y = nsa::pkbf(ST[j][4 * q4 + 2], ST[j][4 * q4 + 3]);
                    *(LAS u32x2*)(L + L_ST + (32 * (2 * dvp + j) + r) * SP + (32 * dkt + 8 * q4 + 4 * h) * 2) = o; }
        }
    }
    if (!PASS2) {
        float* sl = P.SLOC + (size_t)it * 16384;
#pragma unroll
        for (int j = 0; j < 2; ++j)
#pragma unroll
            for (int i = 0; i < 16; ++i) sl[(32 * dkt + 8 * (i >> 2) + 4 * h + (i & 3)) * 128 + 32 * (2 * dvp + j) + r] = ST[j][i];
        if (tq8 == 0) { P.LSUM[(size_t)it * 128 + 2 * d2] = lsum_d[0]; P.LSUM[(size_t)it * 128 + 2 * d2 + 1] = lsum_d[1]; }
    }
}
#undef HG_MFMA
#undef HDI
}


namespace wg {
typedef float f32x16 __attribute__((ext_vector_type(16)));
typedef short s16x8 __attribute__((ext_vector_type(8)));
typedef short s16x4 __attribute__((ext_vector_type(4)));
#define WG_MFMA(a, b, c) __builtin_amdgcn_mfma_f32_32x32x16_bf16((a), (b), (c), 0, 0, 0)
__device__ __forceinline__ void router_partial(const bf16* XNB, const bf16* WRT, LAS float* red, int item, int kq, int w, int lane) {
    const int r = lane & 31, h = lane >> 5; const size_t tok0 = (size_t)item * 32;
    f32x16 acc[3];
#pragma unroll
    for (int nt = 0; nt < 3; ++nt)
#pragma unroll
        for (int i = 0; i < 16; ++i) acc[nt][i] = 0.f;
    const bf16* ap = XNB + (tok0 + r) * 2048 + 512 * kq + 8 * h; const bf16* bp = WRT + (size_t)r * 2048 + 512 * kq + 8 * h;
#pragma unroll 8
    for (int s = 0; s < 32; ++s) { const s16x8 a = *(const s16x8*)(ap + 16 * s);
#pragma unroll
        for (int nt = 0; nt < 3; ++nt) { const s16x8 b = *(const s16x8*)(bp + (size_t)nt * 32 * 2048 + 16 * s); acc[nt] = WG_MFMA(a, b, acc[nt]); } }
#pragma unroll
    for (int nt = 0; nt < 3; ++nt)
#pragma unroll
        for (int i = 0; i < 16; ++i) red[(w * 48 + nt * 16 + i) * 64 + lane] = acc[nt][i];
}
__device__ __forceinline__ void router_reduce(const LAS float* red, const float* BR, float* RLOG, int item, int kq, int w, int lane) {
    if (kq < 3) { const int r = lane & 31, h = lane >> 5, nt = kq, w0 = w & ~3; const size_t tok0 = (size_t)item * 32; const float bias = BR[32 * nt + r];
#pragma unroll
        for (int i = 0; i < 16; ++i) { const int o = (nt * 16 + i) * 64 + lane;
            const float v = (red[(w0 * 48) * 64 + o] + red[((w0 + 1) * 48) * 64 + o]) + (red[((w0 + 2) * 48) * 64 + o] + red[((w0 + 3) * 48) * 64 + o]);
            RLOG[(tok0 + 8 * (i >> 2) + 4 * h + (i & 3)) * 128 + 32 * nt + r] = v + bias; } }
}
__device__ __forceinline__ void compress_block(const bf16* src  , const float* pe  , const bf16* W1F  , const bf16* W2T  , bf16* outp  ,
                                               LAS float* red, int item, int w, int lane) {
    const int r = lane & 31, h = lane >> 5;
    const int row = item * 32 + r;
    constexpr int AP = 4112;
    LAS char* Ab = (LAS char*)red; LAS float* pes = (LAS float*)(Ab + 32 * AP);
    { const int tid = w * 64 + lane;
      for (int i = tid; i < 512; i += 512) *(LAS f32x4*)(pes + 4 * i) = *(const f32x4*)(pe + 4 * i);
      __syncthreads();
#pragma unroll 8
      for (int j = 0; j < 16; ++j) { const int p = tid + 512 * j, rr = p >> 8, l = (p >> 3) & 31, q = p & 7;
          const int rw = item * 32 + rr, rc = rw < 4080 ? rw : 4079, bg = rc / NCMP, ic = rc % NCMP;
          const u32x4 raw = *(const u32x4*)(src + ((size_t)(bg >> 2) * S + 16 * ic + l) * 256 + (bg & 3) * 64 + 8 * q);
          const f32x4 p0 = *(const LAS f32x4*)(pes + l * 64 + 8 * q), p1 = *(const LAS f32x4*)(pes + l * 64 + 8 * q + 4);
          u32x4 av; av.x = nsa::pkbf(bf_lo(raw.x) + p0[0], bf_hi(raw.x) + p0[1]); av.y = nsa::pkbf(bf_lo(raw.y) + p0[2], bf_hi(raw.y) + p0[3]);
          av.z = nsa::pkbf(bf_lo(raw.z) + p1[0], bf_hi(raw.z) + p1[1]); av.w = nsa::pkbf(bf_lo(raw.w) + p1[2], bf_hi(raw.w) + p1[3]);
          *(LAS u32x4*)(Ab + rr * AP + (l * 64 + 8 * q) * 2) = av; }
      __syncthreads(); }
    f32x16 acc;
#pragma unroll
    for (int i = 0; i < 16; ++i) acc[i] = 0.f;
    const bf16* wp = W1F + ((size_t)w * 128 * 64 + lane) * 8;
    const LAS char* ap = Ab + r * AP + 16 * h;
    s16x8 wq[2][16];
#define CB_LOAD(q, s0) do { _Pragma("unroll") for (int j_ = 0; j_ < 16; ++j_) wq[q][j_] = *(const s16x8*)(wp + (size_t)((s0) + j_) * 512); } while (0)
#define CB_MMA(q, s0) do { _Pragma("unroll") for (int j_ = 0; j_ < 16; ++j_) { const s16x8 av = *(const LAS s16x8*)(ap + 32 * ((s0) + j_)); acc = WG_MFMA(wq[q][j_], av, acc); } } while (0)
    CB_LOAD(0, 0);
#pragma unroll 1
    for (int s = 0; s < 128; s += 32) {
        CB_LOAD(1, s + 16); __builtin_amdgcn_sched_barrier(0); CB_MMA(0, s); __builtin_amdgcn_sched_barrier(0);
        if (s + 32 < 128) CB_LOAD(0, s + 32);
        __builtin_amdgcn_sched_barrier(0); CB_MMA(1, s + 16); __builtin_amdgcn_sched_barrier(0); }
#undef CB_LOAD
#undef CB_MMA
    __syncthreads();
    f32x16 o[2];
#pragma unroll
    for (int dt = 0; dt < 2; ++dt)
#pragma unroll
        for (int i = 0; i < 16; ++i) o[dt][i] = 0.f;
#pragma unroll
    for (int sp = 0; sp < 2; ++sp) { u32x4 pw; float hv[8];
#pragma unroll
        for (int j = 0; j < 8; ++j) { const float x = acc[8 * sp + j]; hv[j] = x * __builtin_amdgcn_rcpf(1.f + __expf(-x)); }
        pw.x = nsa::pkbf(hv[0], hv[1]); pw.y = nsa::pkbf(hv[2], hv[3]); pw.z = nsa::pkbf(hv[4], hv[5]); pw.w = nsa::pkbf(hv[6], hv[7]);
        const s16x8 pf = __builtin_bit_cast(s16x8, pw);
#pragma unroll
        for (int dt = 0; dt < 2; ++dt) { const bf16* w2 = W2T + (size_t)(32 * dt + r) * 256 + 32 * w + 16 * sp + 4 * h;
            const s16x4 lo = *(const s16x4*)w2, hi = *(const s16x4*)(w2 + 8);
            o[dt] = WG_MFMA(__builtin_shufflevector(lo, hi, 0, 1, 2, 3, 4, 5, 6, 7), pf, o[dt]); } }
#pragma unroll
    for (int dt = 0; dt < 2; ++dt)
#pragma unroll
        for (int i = 0; i < 16; ++i) red[(w * 32 + dt * 16 + i) * 64 + lane] = o[dt][i];
    __syncthreads();
    { const int dt = w >> 2, q4 = w & 3; float v[4];
#pragma unroll
      for (int j = 0; j < 4; ++j) { float a = 0.f;
#pragma unroll
          for (int ws = 0; ws < 8; ++ws) a += red[(ws * 32 + dt * 16 + 4 * q4 + j) * 64 + lane];
          v[j] = a; }
      if (row < 4080) { u32x2 ov; ov.x = nsa::pkbf(v[0], v[1]); ov.y = nsa::pkbf(v[2], v[3]); *(u32x2*)(outp + (size_t)row * 64 + 32 * dt + 8 * q4 + 4 * h) = ov; } }
    __syncthreads();
}
#undef WG_MFMA
}

__device__ __forceinline__ void ph_hgrn_rec(const Frame& F) {
    { const hg::Ptrs P{F.w<bf16>(WS_QH), F.w<bf16>(WS_LOGF), F.w<bf16>(WS_VH), F.w<bf16>(WS_GH), F.i_hg_norm_g, F.w<bf16>(WS_MIXB), F.w<float>(WS_SLOC), F.w<float>(WS_LSUM)};
      for (int it = blockIdx.x; it < 256; it += gridDim.x) hg::item<false>(P, (LAS char*)F.lds, F.tid, F.wave, it); }
    __syncthreads();
    for (int it = blockIdx.x; it < 256; it += gridDim.x) { const int which = it >> 7;
        wg::compress_block(F.w<bf16>(WS_KV6) + (size_t)which * T * 256, which ? F.i_pe_v : F.i_pe_k, F.w<bf16>(WS_W1T) + (size_t)which * 256 * 2048, F.w<bf16>(WS_W2T) + (size_t)which * 64 * 256,
                           F.w<bf16>(which ? WS_VCB : WS_KCB), (LAS float*)F.lds, it & 127, F.wave, F.lane); }
}

__device__ __forceinline__ void ph_hgrn_norm_cmp1(const Frame& F) {
    { const hg::Ptrs P{F.w<bf16>(WS_QH), F.w<bf16>(WS_LOGF), F.w<bf16>(WS_VH), F.w<bf16>(WS_GH), F.i_hg_norm_g, F.w<bf16>(WS_MIXB), F.w<float>(WS_SLOC), F.w<float>(WS_LSUM)};
      for (int it = blockIdx.x; it < 256; it += gridDim.x) hg::item<true>(P, (LAS char*)F.lds, F.tid, F.wave, it); }
}
__device__ __forceinline__ void ph_attn(const Frame& F) {
    const nsa::Ptrs P{F.w<bf16>(WS_QN), F.w<bf16>(WS_KV6), F.w<float>(WS_GATE), F.w<bf16>(WS_KCB), F.w<bf16>(WS_VCB), F.i_rel_bias, F.w<bf16>(WS_MIXB)};
    for (int su = blockIdx.x; su < 256; su += gridDim.x) { const int bg = su >> 4, j = su & 15;
        for (int q = 0; q < 4; ++q) { const int c = q == 0 ? 63 - j : (q == 1 ? 32 + j : (q == 2 ? 31 - j : j)); nsa::attn_unit(P, (LAS char*)F.lds, F.tid, F.wave, bg >> 2, bg & 3, c); } }
}
__device__ __forceinline__ void ph_outproj(const Frame& F) {
    pg8::Gemm g{F.w<bf16>(WS_MIXB), F.w<bf16>(WS_WOUTT), T, D, D}; pg8::StaticOrder So; So.init(T, D, (int)gridDim.x, (int)blockIdx.x);
    pg8::EpiRes E{F.w<pg8::bf16_t>(WS_X2), F.i_x, D};
    pg8::gemm_phase<pg8::EpiRes, pg8::StaticOrder, true, true>(F.lds, g, So, E, F.wave);
}
__device__ __forceinline__ void route_token(const float* RLOG, int* cnt, int* LISTI, float* LISTW, int t) {
        const float* lg = RLOG + (size_t)t * 128;
        float m = lg[0]; int gt = 0;
#pragma unroll
        for (int j = 1; j < 8; ++j) if (lg[j] > m) { m = lg[j]; gt = j; }
        float sum = 0.f;
#pragma unroll
        for (int j = 0; j < 8; ++j) sum += expf(lg[j] - m);
        const float ptop = 1.f / sum;
        const float* le = lg + 8 + gt * 8;
        float v0 = le[0]; int i0 = 0;
#pragma unroll
        for (int j = 1; j < 8; ++j) if (le[j] > v0) { v0 = le[j]; i0 = j; }
        float v1 = -3e38f; int i1 = -1;
#pragma unroll
        for (int j = 0; j < 8; ++j) if (j != i0 && (i1 < 0 || le[j] > v1)) { v1 = le[j]; i1 = j; }
        const float e1 = expf(v1 - v0), w0 = 1.f / (1.f + e1), w1 = e1 / (1.f + e1);
        const int ex0 = gt * 8 + i0, ex1 = gt * 8 + i1;
        const int p0 = atomicAdd(&cnt[ex0 * CNT_STRIDE], 1), p1 = atomicAdd(&cnt[ex1 * CNT_STRIDE], 1);
        LISTI[ex0 * 16384 + p0] = 2 * t; LISTW[ex0 * 16384 + p0] = ptop * w0; LISTI[ex1 * 16384 + p1] = 2 * t + 1; LISTW[ex1 * 16384 + p1] = ptop * w1;
}
__device__ __forceinline__ void ph_router_logits(const Frame& F) {
    LAS float* red = (LAS float*)F.lds;
    const bf16* X2 = F.w<bf16>(WS_X2); const float* g2 = F.i_norm2_g; bf16* XNB = F.w<bf16>(WS_XNB);
    for (int it0 = blockIdx.x * 2; it0 < T / 32; it0 += gridDim.x * 2) { const int item = it0 + (F.wave >> 2), kq = F.wave & 3;
        { u32x2 xa[8][8];
          const int m0 = it0 * 32 + F.wave * 8;
#pragma unroll
          for (int j8 = 0; j8 < 8; ++j8) { const u32x2* xr = (const u32x2*)(X2 + (size_t)(m0 + j8) * D);
#pragma unroll
              for (int j = 0; j < 8; ++j) xa[j8][j] = xr[F.lane + 64 * j]; }
#pragma unroll
          for (int j8 = 0; j8 < 8; ++j8) { float ss = 0.f;
#pragma unroll
              for (int j = 0; j < 8; ++j) { const u32x2 a = xa[j8][j]; const float x0 = bf_lo(a.x), x1 = bf_hi(a.x), x2 = bf_lo(a.y), x3 = bf_hi(a.y); ss += x0 * x0 + x1 * x1 + x2 * x2 + x3 * x3; }
              const float rr = rsqrtf(wave_sum(ss) * (1.f / D) + EPS);
              u32x2* hb = (u32x2*)(XNB + (size_t)(m0 + j8) * D);
#pragma unroll
              for (int j = 0; j < 8; ++j) { const u32x2 a = xa[j8][j]; const float4 g = ((const float4*)g2)[F.lane + 64 * j]; u32x2 ob; ob.x = pk2(bf_lo(a.x) * rr * g.x, bf_hi(a.x) * rr * g.y); ob.y = pk2(bf_lo(a.y) * rr * g.z, bf_hi(a.y) * rr * g.w); hb[F.lane + 64 * j] = ob; } } }
        asm volatile("s_waitcnt vmcnt(0)" ::: "memory");
        __syncthreads();
        wg::router_partial(F.w<bf16>(WS_XNB), F.w<bf16>(WS_WRT), red, item, kq, F.wave, F.lane);
        __syncthreads();
        wg::router_reduce(red, F.w<float>(WS_BR), F.w<float>(WS_RLOG), item, kq, F.wave, F.lane);
        asm volatile("s_waitcnt vmcnt(0)" ::: "memory");
        __syncthreads();
        if (kq == 0 && F.lane < 32) route_token(F.w<float>(WS_RLOG), F.w<int>(WS_CTL) + CW_CNT, F.w<int>(WS_LISTI), F.w<float>(WS_LISTW), item * 32 + F.lane); }
}
constexpr int LDS_TAB = 131072;
__device__ __forceinline__ void expert_offsets(const Frame& F, LAS int* offs, LAS int* cnts, LAS int* rt_exp) {
    const int* cnt = F.w<int>(WS_CTL) + CW_CNT;
    __syncthreads();
    if (F.wave == 0) {
        const int e = F.lane, cn = cnt[e * CNT_STRIDE], n = (cn + 255) >> 8;
        int inc = n;
#pragma unroll
        for (int o = 1; o < 64; o <<= 1) { const int v = __shfl_up(inc, o); if (e >= o) inc += v; }
        const int excl = inc - n;
        cnts[e] = cn; offs[e] = excl * 256; if (e == 63) offs[64] = inc * 256;
        for (int j = 0; j < n; ++j) rt_exp[excl + j] = e;
    }
    __syncthreads();
}
__device__ __forceinline__ void ph_moe1(const Frame& F) {
    LAS int* offs = (LAS int*)(F.lds + LDS_TAB); LAS int* cnts = offs + 128; LAS int* rt_exp = offs + 256;
    expert_offsets(F, offs, cnts, rt_exp);
    pg8::GroupedOrder So; So.init(rt_exp, (offs[64] >> 8) * 8, (int)gridDim.x, (int)blockIdx.x);
    pg8::EpiSwiGLU E{F.w<bf16>(WS_HID)};
    pg8::moe_gemm<pg8::EpiSwiGLU, true>(F.lds, F.w<bf16>(WS_XNB), F.w<int>(WS_LISTI), F.i_weg, F.i_weu, offs, cnts, So, E, F.wave);
}
__device__ __forceinline__ void ph_moe2(const Frame& F) {
    LAS int* offs = (LAS int*)(F.lds + LDS_TAB); LAS int* cnts = offs + 128; LAS int* rt_exp = offs + 256;
    expert_offsets(F, offs, cnts, rt_exp);
    pg8::GroupedOrder So; So.init(rt_exp, (offs[64] >> 8) * 8, (int)gridDim.x, (int)blockIdx.x);
    pg8::EpiMoeOut E{F.w<bf16>(WS_Y2), F.w<int>(WS_LISTI), F.w<float>(WS_LISTW), offs, cnts};
    pg8::moe_gemm<pg8::EpiMoeOut, false>(F.lds, F.w<bf16>(WS_HID), F.w<int>(WS_LISTI), F.i_wed, F.i_wed, offs, cnts, So, E, F.wave);
}
__device__ __forceinline__ void ph_final(const Frame& F) {
    const bf16* X2 = F.w<bf16>(WS_X2); const bf16* Y2 = F.w<bf16>(WS_Y2); const float* gf = F.i_final_g;
    u32x2 xa[8], ya[8], yb[8], xn[8], yan[8], ybn[8];
    int m = F.gw;
    if (m < T) { const u32x2* xr = (const u32x2*)(X2 + (size_t)m * D); const u32x2* y0 = (const u32x2*)(Y2 + (size_t)(2 * m) * D); const u32x2* y1 = (const u32x2*)(Y2 + (size_t)(2 * m + 1) * D);
#pragma unroll
        for (int j = 0; j < 8; ++j) { xa[j] = __builtin_nontemporal_load(xr + F.lane + 64 * j); ya[j] = __builtin_nontemporal_load(y0 + F.lane + 64 * j); yb[j] = __builtin_nontemporal_load(y1 + F.lane + 64 * j); } }
    for (; m < T; m += F.NGW) {
        const int mn = m + F.NGW;
        if (mn < T) { const u32x2* xr = (const u32x2*)(X2 + (size_t)mn * D); const u32x2* y0 = (const u32x2*)(Y2 + (size_t)(2 * mn) * D); const u32x2* y1 = (const u32x2*)(Y2 + (size_t)(2 * mn + 1) * D);
#pragma unroll
            for (int j = 0; j < 8; ++j) { xn[j] = __builtin_nontemporal_load(xr + F.lane + 64 * j); yan[j] = __builtin_nontemporal_load(y0 + F.lane + 64 * j); ybn[j] = __builtin_nontemporal_load(y1 + F.lane + 64 * j); } }
        f32x4 v[8]; float ss = 0.f;
#pragma unroll
        for (int j = 0; j < 8; ++j) { const u32x2 a2 = xa[j], b = ya[j], c = yb[j];
            v[j] = (f32x4){bf_lo(a2.x) + (bf_lo(b.x) + bf_lo(c.x)), bf_hi(a2.x) + (bf_hi(b.x) + bf_hi(c.x)), bf_lo(a2.y) + (bf_lo(b.y) + bf_lo(c.y)), bf_hi(a2.y) + (bf_hi(b.y) + bf_hi(c.y))};
            ss += v[j].x * v[j].x + v[j].y * v[j].y + v[j].z * v[j].z + v[j].w * v[j].w; }
        const float r = rsqrtf(wave_sum(ss) * (1.f / D) + EPS);
        f32x4* orow = (f32x4*)(F.out + (size_t)m * D);
#pragma unroll
        for (int j = 0; j < 8; ++j) { const float4 g = ((const float4*)gf)[F.lane + 64 * j]; __builtin_nontemporal_store((f32x4){v[j].x * r * g.x, v[j].y * r * g.y, v[j].z * r * g.z, v[j].w * r * g.w}, orow + F.lane + 64 * j); }
#pragma unroll
        for (int j = 0; j < 8; ++j) { xa[j] = xn[j]; ya[j] = yan[j]; yb[j] = ybn[j]; }
    }
}

constexpr int NPHASE = 10;
__global__ void __launch_bounds__(NTHR, 2) fwd(Args args) {
    extern __shared__ __attribute__((aligned(16))) unsigned char lds_raw[];
    const int wv = __builtin_amdgcn_readfirstlane((int)threadIdx.x >> 6);
    LAS unsigned char* lds0 = (LAS unsigned char*)lds_raw;
    volatile LAS unsigned* xbw = (volatile LAS unsigned*)(lds0 + LDS_BYTES - 16);
    if (wv == 0 && lane_id() == 0) { xbw[0] = 0u; xbw[1] = 0u; }
    __syncthreads();
    unsigned* barw = (unsigned*)(args.ws + WS_CTL) + CW_BAR + args.li * XCD_BAR_WORDS;
    XcdBarrier bar; bar.bar = barw; bar.x = 0; bar.st = xbw; bar.wave = wv;
    const int lo = args.ph_lo, hi = args.ph_hi;
    if (hi - lo > 1) bar = xcd_barrier_post(barw, xbw, wv);
#define IN(k) (lo <= (k) && (k) < hi)
#define SEAM(k) do { if (IN(k) && IN((k) + 1)) xcd_barrier(bar); } while (0)
    if (IN(0)) ph_prologue(relocal(wv));          SEAM(0);
    if (IN(1)) ph_inproj(relocal(wv));            SEAM(1);
    if (IN(2)) ph_hgrn_rec(relocal(wv));          SEAM(2);
    if (IN(3)) ph_hgrn_norm_cmp1(relocal(wv));    if (IN(3) && IN(4)) __syncthreads();
    if (IN(4)) ph_attn(relocal(wv));              SEAM(4);
    if (IN(5)) ph_outproj(relocal(wv));           SEAM(5);
    if (IN(6)) ph_router_logits(relocal(wv));     SEAM(6);
    if (IN(7)) ph_moe1(relocal(wv));              SEAM(7);
    if (IN(8)) ph_moe2(relocal(wv));              SEAM(8);
    if (IN(9)) ph_final(relocal(wv));
#undef IN
#undef SEAM
}

extern "C" void kernel_launch(void* const* d_in, const int* in_sizes, int n_in, void* d_out, int out_size, void* d_ws, size_t ws_size, hipStream_t stream) {
    static int grid = 0;
    if (grid == 0) {
        if (n_in != 22 || out_size != T * D || ws_size < WS_END) { fprintf(stderr, "kernel_launch: unexpected shapes: n_in %d out %d ws %zu (need %zu)\n", n_in, out_size, ws_size, (size_t)WS_END); grid = -1; return; }
        int dev = 0, cus = 0, per_cu = 0;
        if (hipGetDevice(&dev) != hipSuccess || hipDeviceGetAttribute(&cus, hipDeviceAttributeMultiprocessorCount, dev) != hipSuccess) { grid = -1; return; }
        if (hipFuncSetAttribute((const void*)fwd, hipFuncAttributeMaxDynamicSharedMemorySize, LDS_BYTES) != hipSuccess) { fprintf(stderr, "kernel_launch: hipFuncSetAttribute failed\n"); grid = -1; return; }
        if (hipOccupancyMaxActiveBlocksPerMultiprocessor(&per_cu, (const void*)fwd, NTHR, LDS_BYTES) != hipSuccess || per_cu < 1) fprintf(stderr, "kernel_launch: occupancy query says %d\n", per_cu);
        (void)hipGetLastError();
        grid = cus;
    }
    if (grid < 0) return;
    (void)hipMemsetAsync((char*)d_ws + WS_CTL, 0, CTL_BYTES, stream);
    Args a{};
    for (int i = 0; i < 22; ++i) a.in[i] = (const float*)d_in[i];
    a.out = (float*)d_out; a.ws = (unsigned char*)d_ws;
#if MK_ONE_LAUNCH
    a.ph_lo = 0; a.ph_hi = NPHASE;
    hipLaunchKernelGGL(fwd, dim3(grid), dim3(NTHR), LDS_BYTES, stream, a);
#else
    for (int p = 0; p < NPHASE; ++p) { a.ph_lo = p; a.ph_hi = p + 1; hipLaunchKernelGGL(fwd, dim3(grid), dim3(NTHR), LDS_BYTES, stream, a); }
#endif
}
```

```cpp
#include <hip/hip_runtime.h>
#include <cstdio>
#include <cstdint>

#ifndef MK_ONE_LAUNCH
#define MK_ONE_LAUNCH 1
#endif

constexpr int D = 2048, NB = 4, S = 4096, T = NB * S;
constexpr int WIN_N = 6704;
constexpr int LDP = 6912;
constexpr int C_HQ = 0, C_HF = 1024, C_HI = 2048, C_HGATE = 3072, C_Q = 4096, C_KC = 5120, C_VC = 5376, C_KS = 5632, C_VS = 5888, C_KW = 6144, C_VW = 6400, C_GATE = 6656;
constexpr int NCMP = 255, NE = 64, DFF = 1024;
constexpr float EPS = 1e-6f;
constexpr int NTHR = 512;
constexpr int LDS_BYTES = 147456;
constexpr int PROWS = 49152;

constexpr size_t MiB = 1u << 20;
constexpr size_t WS_CTL = 0, CTL_BYTES = 1 * MiB;
constexpr size_t WS_LB = 1 * MiB;
constexpr size_t WS_BR = 1 * MiB + 65536;
constexpr size_t WS_LISTI = 16 * MiB;
constexpr size_t WS_LISTW = 20 * MiB;
constexpr size_t WS_WRT = 9 * MiB;
constexpr size_t WS_W1T = 10 * MiB;
constexpr size_t WS_W2T = 12 * MiB;
constexpr size_t WS_KCB = 13 * MiB;
constexpr size_t WS_VCB = 14 * MiB;
constexpr size_t WS_QH = 144 * MiB;
constexpr size_t WS_LOGF = 176 * MiB;
constexpr size_t WS_VH = 240 * MiB;
constexpr size_t WS_GH = 272 * MiB;
constexpr size_t WS_QN = 304 * MiB;
constexpr size_t WS_KV6 = 336 * MiB;
constexpr size_t WS_GATE = 384 * MiB;
constexpr size_t WS_HID = 144 * MiB;
constexpr size_t WS_Y2 = 240 * MiB;
constexpr size_t WS_XS = 368 * MiB;
constexpr size_t WS_SLOC = 1856 * MiB;
constexpr size_t WS_LSUM = 1872 * MiB;
constexpr size_t WS_MIXB = 640 * MiB;
constexpr size_t WS_X2 = 784 * MiB;
constexpr size_t WS_RLOG = 912 * MiB;
constexpr size_t WS_HB = 920 * MiB;
constexpr size_t WS_WINT = 984 * MiB;
constexpr size_t WS_WOUTT = 1012 * MiB;
constexpr size_t WS_WGUT = 1024 * MiB;
constexpr size_t WS_WDT = 1536 * MiB;
constexpr size_t WS_XNB = 1792 * MiB;
constexpr size_t WS_END = 1873 * MiB;
constexpr int CW_CNT = 65536, CNT_STRIDE = 64;
constexpr int CW_BAR = 4096;

#define LAS __attribute__((address_space(3)))
typedef float f32x4 __attribute__((ext_vector_type(4)));

struct Args { const float* in[22]; float* out; unsigned char* ws; int ph_lo, ph_hi, li, pad; };

#define XB_TMO      128
#define XB_XCNT(j)  (256  + 64 * (j))
#define XB_XSUB(j)  (1280 + 64 * (j))
#define XB_XGEN(j)  (2304 + 64 * (j))
#define XB_TOP      3328
#define XB_TOPGEN   3392
#define XCD_BAR_WORDS 3456
#define XB_SPIN_CAP (1u << 22)

__device__ __forceinline__ unsigned xb_ld(unsigned* p)              { return __hip_atomic_load(p, __ATOMIC_RELAXED, __HIP_MEMORY_SCOPE_AGENT); }
__device__ __forceinline__ unsigned xb_add(unsigned* p, unsigned v) { return __hip_atomic_fetch_add(p, v, __ATOMIC_RELAXED, __HIP_MEMORY_SCOPE_AGENT); }
__device__ __forceinline__ unsigned xb_xcc_id() { return (unsigned)__builtin_amdgcn_s_getreg((3 << 11) | 20) & 0xFu; }
#define XB_SPIN(cond, bar) do { unsigned _sp = 0; while (cond) { __builtin_amdgcn_s_sleep(1); \
    if ((++_sp & 255u) == 0u) { if (xb_ld(&(bar)[XB_TMO])) break; if (_sp > XB_SPIN_CAP) { atomicAdd(&(bar)[XB_TMO], 1u); break; } } } } while (0)

struct XcdBarrier { unsigned* bar; unsigned x; volatile LAS unsigned* st; int wave; };
__device__ __forceinline__ int lane_id() { return (int)__builtin_amdgcn_mbcnt_hi(~0u, __builtin_amdgcn_mbcnt_lo(~0u, 0u)); }

__device__ __forceinline__ XcdBarrier xcd_barrier_post(unsigned* bar, volatile LAS unsigned* st, int wave) {
    XcdBarrier b; b.bar = bar; b.x = xb_xcc_id(); b.st = st; b.wave = wave;
    if (b.wave == 0 && lane_id() == 0) (void)xb_add(&bar[XB_XCNT(b.x)], 1u);
    return b;
}
__device__ __forceinline__ void xcd_barrier_complete(unsigned* bar, unsigned x, unsigned& nloc, unsigned& nx) {
    const unsigned G = gridDim.x * gridDim.y * gridDim.z;
    unsigned sum, cnt, mine, sp = 0u;
    for (;;) {
        sum = 0u; cnt = 0u; mine = 0u;
#pragma unroll
        for (unsigned j = 0; j < 16; ++j) { const unsigned c = xb_ld(&bar[XB_XCNT(j)]); sum += c; cnt += (c > 0u) ? 1u : 0u; mine = (j == x) ? c : mine; }
        if (sum == G) break;
        __builtin_amdgcn_s_sleep(1);
        if ((++sp & 255u) == 0u) { if (xb_ld(&bar[XB_TMO])) break; if (sp > XB_SPIN_CAP) { atomicAdd(&bar[XB_TMO], 1u); break; } }
    }
    nloc = mine > 0u ? mine : 1u; nx = cnt > 0u ? cnt : 1u;
}
__device__ __forceinline__ void xcd_barrier(const XcdBarrier& b) {
    asm volatile("s_waitcnt vmcnt(0)" ::: "memory");
    __syncthreads();
    if (b.wave == 0 && lane_id() == 0) {
        unsigned* bar = b.bar;
        __builtin_amdgcn_s_waitcnt(0);
        unsigned nloc = b.st[0], nx = b.st[1];
        if (nloc == 0u) { xcd_barrier_complete(bar, b.x, nloc, nx); b.st[0] = nloc; b.st[1] = nx; }
        const unsigned old = xb_add(&bar[XB_XSUB(b.x)], 1u);
        const unsigned gen = old / nloc;
        if (old + 1u == (gen + 1u) * nloc) {
            __builtin_amdgcn_fence(__ATOMIC_RELEASE, "agent");
            asm volatile("s_waitcnt vmcnt(0)" ::: "memory");
            const unsigned og = xb_add(&bar[XB_TOP], 1u);
            const unsigned tg = og / nx;
            if (og + 1u == (tg + 1u) * nx) xb_add(&bar[XB_TOPGEN], 1u);
            else XB_SPIN(xb_ld(&bar[XB_TOPGEN]) == tg, bar);
            __builtin_amdgcn_fence(__ATOMIC_ACQUIRE, "agent");
            xb_add(&bar[XB_XGEN(b.x)], 1u);
            asm volatile("s_waitcnt vmcnt(0)" ::: "memory");
        } else {
            XB_SPIN(xb_ld(&bar[XB_XGEN(b.x)]) == gen, bar);
            __builtin_amdgcn_fence(__ATOMIC_ACQUIRE, "agent");
            asm volatile("s_waitcnt vmcnt(0)" ::: "memory");
        }
    }
    __syncthreads();
}

#ifndef MOE_TAIL_TEST
#define MOE_TAIL_TEST 0
#define MOE_TAIL_WAYS 4
#endif
namespace pg8 {
#define PG8_LAS __attribute__((address_space(3)))
typedef unsigned short bf16_t;
typedef short bf16x8 __attribute__((ext_vector_type(8)));
typedef float f32x4 __attribute__((ext_vector_type(4)));
typedef unsigned u32x4 __attribute__((ext_vector_type(4)));
typedef unsigned u32x2p __attribute__((ext_vector_type(2)));
constexpr int BM = 256, BK = 64, HALF = 128, HTB = HALF * BK * 2  , STAGE_BYTES = 8 * HTB, NXCD = 8, WGM = 8;

__host__ __device__ __forceinline__ int lds_byte(int r, int c) { const int st = (r >> 4) * 2 + (c >> 5), rr = r & 15, cc = c & 31, ob = rr * 64 + cc * 2; return st * 1024 + (ob ^ (((ob >> 9) & 1) << 5)); }
__host__ __device__ __forceinline__ void stage_rc(int b, int& R, int& C) { const int st = b / 1024, sb = b % 1024, swz = sb ^ (((sb >> 9) & 1) << 5); R = (st >> 1) * 16 + swz / 64; C = (st & 1) * 32 + (swz % 64) / 2; }
__host__ __device__ __forceinline__ int perm32(int rho) { const int n = rho >> 4, i = rho & 15; return 8 * (i >> 2) + 4 * n + (i & 3); }

struct Unit { int pm, pn, sub; };
struct Gemm { const bf16_t* A; const bf16_t* Bt; int M, N, K; };

struct StaticOrder {
    int nM, nN, nwg, G, c;
    __host__ __device__ void init(int M, int N, int G_, int c_) { nM = M / BM; nN = N / BM; nwg = nM * nN; G = G_; c = c_; }
    __host__ __device__ bool next(int i, Unit& u) const {
        const long L = (long)i * G + c; if (L >= nwg) return false;
        int wgid = (int)L; { const int q = nwg / NXCD, r = nwg % NXCD, xcd = wgid % NXCD, off = wgid / NXCD; wgid = (xcd < r ? xcd * (q + 1) : r * (q + 1) + (xcd - r) * q) + off; }
        const int nig = WGM * nN, gid = wgid / nig, fm = gid * WGM, gsz = (nM - fm) < WGM ? (nM - fm) : WGM;
        u.pm = fm + ((wgid % nig) % gsz); u.pn = (wgid % nig) / gsz; return true;
    }
    __device__ __forceinline__ void a_ready(const Unit&) const {}
    __device__ __forceinline__ void done(const Unit&) const {}
};


__device__ __forceinline__ unsigned cvt_pk_bf16(float lo, float hi) { unsigned r; asm volatile("v_cvt_pk_bf16_f32 %0, %1, %2" : "=v"(r) : "v"(lo), "v"(hi)); return r; }
struct EpiF32 {
    static constexpr bool PERM = false, AFTER_DRAIN = false;
    float* C; int ldc;
    __device__ __forceinline__ void operator()(const f32x4 (&acc)[2][2][4][2], const Unit& u, int wr, int wc, int fr, int fq) const {
        const int row0 = u.pm * BM + wr * 64 + fr, col0 = u.pn * BM + wc * 32 + 4 * fq;
#pragma unroll
        for (int ai = 0; ai < 2; ++ai)
#pragma unroll
            for (int m = 0; m < 4; ++m) { float* rowp = C + (size_t)(row0 + ai * HALF + m * 16) * ldc + col0;
#pragma unroll
                for (int bj = 0; bj < 2; ++bj)
#pragma unroll
                    for (int n = 0; n < 2; ++n) *(f32x4*)(rowp + bj * HALF + n * 16) = acc[ai][bj][m][n]; }
    }
};
struct EpiRes {
    static constexpr bool PERM = false, AFTER_DRAIN = false;
    bf16_t* C; const float* R; int ldc;
    __device__ __forceinline__ void operator()(const f32x4 (&acc)[2][2][4][2], const Unit& u, int wr, int wc, int fr, int fq) const {
        const int row0 = u.pm * BM + wr * 64 + fr, col0 = u.pn * BM + wc * 32 + 4 * fq;
#pragma unroll
        for (int ai = 0; ai < 2; ++ai) {
            f32x4 rv[4][2][2];
#pragma unroll
            for (int m = 0; m < 4; ++m) { const size_t off = (size_t)(row0 + ai * HALF + m * 16) * ldc + col0;
#pragma unroll
                for (int bj = 0; bj < 2; ++bj)
#pragma unroll
                    for (int n = 0; n < 2; ++n) rv[m][bj][n] = __builtin_nontemporal_load((const f32x4*)(R + off + bj * HALF + n * 16)); }
            __builtin_amdgcn_sched_barrier(0);
#pragma unroll
            for (int m = 0; m < 4; ++m) { const size_t off = (size_t)(row0 + ai * HALF + m * 16) * ldc + col0;
#pragma unroll
                for (int bj = 0; bj < 2; ++bj)
#pragma unroll
                    for (int n = 0; n < 2; ++n) { const f32x4 v = rv[m][bj][n] + acc[ai][bj][m][n];
                        u32x2p o; o.x = cvt_pk_bf16(v[0], v[1]); o.y = cvt_pk_bf16(v[2], v[3]);
                        *(u32x2p*)(C + off + bj * HALF + n * 16) = o; } }
            __builtin_amdgcn_sched_barrier(0); }
    }
};

struct EpiSwiGLU {
    static constexpr bool PERM = true, AFTER_DRAIN = false;
    bf16_t* HID;
    __device__ __forceinline__ void operator()(const f32x4 (&acc)[2][2][4][2], const Unit& u, int wr, int wc, int fr, int fq) const {
        const int row0 = u.pm * BM + wr * 64 + fr, col0 = (u.pn & 7) * 128 + wc * 32 + 8 * fq;
#pragma unroll
        for (int ai = 0; ai < 2; ++ai)
#pragma unroll
            for (int m = 0; m < 4; ++m) { bf16_t* rowp = HID + (size_t)(row0 + ai * HALF + m * 16) * 1024 + col0;
                float h[8];
#pragma unroll
                for (int n = 0; n < 2; ++n)
#pragma unroll
                    for (int i = 0; i < 4; ++i) { const float gv = acc[ai][0][m][n][i], uv = acc[ai][1][m][n][i]; h[n * 4 + i] = gv * __builtin_amdgcn_rcpf(1.f + __expf(-gv)) * uv; }
                u32x4 w; w.x = cvt_pk_bf16(h[0], h[1]); w.y = cvt_pk_bf16(h[2], h[3]); w.z = cvt_pk_bf16(h[4], h[5]); w.w = cvt_pk_bf16(h[6], h[7]);
                *(u32x4*)rowp = w; }
    }
};
struct EpiMoeOut {
    static constexpr bool PERM = true, AFTER_DRAIN = false;
    bf16_t* Y2; const int* tsi; const float* wrow; const PG8_LAS int* offs; const PG8_LAS int* cnts;
    __device__ __forceinline__ void operator()(const f32x4 (&acc)[2][2][4][2], const Unit& u, int wr, int wc, int fr, int fq) const {
        const int e = u.pn >> 3, lim = offs[e] + cnts[e], lb = e * 16384 - offs[e];
        const int row0 = u.pm * BM + wr * 64 + fr, col0 = (u.pn & 7) * BM + wc * 32 + 8 * fq;
#pragma unroll
        for (int ai = 0; ai < 2; ++ai)
#pragma unroll
            for (int m = 0; m < 4; ++m) { const int p = row0 + ai * HALF + m * 16;
                if (p < lim) { const float w = wrow[lb + p]; bf16_t* rowp = Y2 + (size_t)tsi[lb + p] * 2048 + col0;
#pragma unroll
                    for (int bj = 0; bj < 2; ++bj) { const f32x4 v0 = acc[ai][bj][m][0] * w, v1 = acc[ai][bj][m][1] * w;
                        u32x4 o; o.x = cvt_pk_bf16(v0[0], v0[1]); o.y = cvt_pk_bf16(v0[2], v0[3]); o.z = cvt_pk_bf16(v1[0], v1[1]); o.w = cvt_pk_bf16(v1[2], v1[3]);
                        *(u32x4*)(rowp + bj * HALF) = o; } } }
    }
};
struct GroupedOrder {
    const PG8_LAS int* rt_exp; int nunits, G, c;
    int nmain, tail, ways;
    __device__ __forceinline__ void init(const PG8_LAS int* rt_exp_, int nunits_, int G_, int c_) {
        rt_exp = rt_exp_; nunits = nunits_; G = G_; c = c_;
        const int r = nunits - ((nunits + G - 1) / G - 1) * G;
        tail = 0; ways = 1;
        if (r * 4 <= G) { tail = r; ways = 4; } else if (r * 2 <= G) { tail = r; ways = 2; }
#if MOE_TAIL_TEST
        tail = MOE_TAIL_TEST < nunits ? MOE_TAIL_TEST : nunits; ways = MOE_TAIL_WAYS;
#endif
        nmain = nunits - tail; }
    __device__ __forceinline__ bool next(int i, Unit& u) const {
        const int nm = c < nmain ? (nmain - c + G - 1) / G : 0;
        int L; u.sub = -1;
        if (i < nm) L = i * G + c;
        else if (i == nm && tail > 0 && c / ways < tail) { L = nmain + c / ways; u.sub = ways == 4 ? (c & 3) : 4 + (c & 1); }
        else return false;
        const int rt = L >> 3; u.pm = rt; u.pn = rt_exp[rt] * 8 + (L & 7); return true; }
    __device__ __forceinline__ void a_ready(const Unit&) const {}
    __device__ __forceinline__ void done(const Unit&) const {}
};

struct EpiProj {
    static constexpr bool PERM = true, AFTER_DRAIN = false;
    bf16_t *QH, *VH, *GH, *QN, *KV6; bf16_t* LOGF; float* GATE; const float* LB;
    __device__ __forceinline__ static u32x4 pack8(const f32x4 a, const f32x4 b) { u32x4 w; w.x = cvt_pk_bf16(a[0], a[1]); w.y = cvt_pk_bf16(a[2], a[3]); w.z = cvt_pk_bf16(b[0], b[1]); w.w = cvt_pk_bf16(b[2], b[3]); return w; }
    __device__ __forceinline__ static f32x4 silu4(const f32x4 v) { f32x4 o; for (int i = 0; i < 4; ++i) o[i] = v[i] * __builtin_amdgcn_rcpf(1.f + __expf(-v[i])); return o; }
    __device__ __forceinline__ void operator()(const f32x4 (&acc)[2][2][4][2], const Unit& u, int wr, int wc, int fr, int fq) const {
        const int pn = u.pn, row0 = u.pm * BM + wr * 64 + fr, cl = wc * 32 + 8 * fq;
#pragma unroll
        for (int ai = 0; ai < 2; ++ai)
#pragma unroll
            for (int m = 0; m < 4; ++m) { const size_t row = (size_t)(row0 + ai * HALF + m * 16);
#pragma unroll
                for (int bj = 0; bj < 2; ++bj) { const int c256 = bj * HALF + cl; f32x4 v0 = acc[ai][bj][m][0], v1 = acc[ai][bj][m][1];
                    if (pn < 4) { *(u32x4*)(QH + row * 1024 + pn * 256 + c256) = pack8(silu4(v0), silu4(v1)); }
                    else if (pn < 8) { const int col = (pn - 4) * 256 + c256; const f32x4 l0 = *(const f32x4*)(LB + col), l1 = *(const f32x4*)(LB + col + 4); f32x4 o0, o1;
                        for (int i = 0; i < 4; ++i) { o0[i] = __logf(l0[i] + (1.f - l0[i]) * __builtin_amdgcn_rcpf(1.f + __expf(-v0[i]))); o1[i] = __logf(l1[i] + (1.f - l1[i]) * __builtin_amdgcn_rcpf(1.f + __expf(-v1[i]))); }
                        *(u32x4*)(LOGF + row * 1024 + col) = pack8(o0, o1); }
                    else if (pn < 12) { *(u32x4*)(VH + row * 1024 + (pn - 8) * 256 + c256) = pack8(v0, v1); }
                    else if (pn < 16) { *(u32x4*)(GH + row * 1024 + (pn - 12) * 256 + c256) = pack8(silu4(v0), silu4(v1)); }
                    else if (pn < 20) { const float sc = 0.125f * 1.4426950408889634f; *(u32x4*)(QN + row * 1024 + (pn - 16) * 256 + c256) = pack8(v0 * sc, v1 * sc); }
                    else if (pn < 26) { *(u32x4*)(KV6 + (size_t)(pn - 20) * ((size_t)16384 * 256) + row * 256 + c256) = pack8(v0, v1); }
                    else if (c256 < 64) { f32x4 o0, o1; for (int i = 0; i < 4; ++i) { o0[i] = __builtin_amdgcn_rcpf(1.f + __expf(-v0[i])); o1[i] = __builtin_amdgcn_rcpf(1.f + __expf(-v1[i])); }
                        *(f32x4*)(GATE + row * 64 + c256) = o0; *(f32x4*)(GATE + row * 64 + c256 + 4) = o1; } } }
    }
};
template <class Epi, class Sched, bool ALIGN_EPI = false, bool SP2 = false>
__device__ __forceinline__ void gemm_phase(PG8_LAS unsigned char* lds, const Gemm g, const Sched& S, const Epi& E, int wave_in) {
    const int wid = __builtin_amdgcn_readfirstlane(wave_in), lane = lane_id(), tid = wid * 64 + lane, wr = wid >> 2, wc = wid & 3, fr = lane & 15, fq = lane >> 4;
    const int K = g.K, nt = K / BK;
    unsigned voffA[2], voffB[2];
#pragma unroll
    for (int i = 0; i < 2; ++i) { int R, C; stage_rc(tid * 16 + i * 8192, R, C); const int Rb = Epi::PERM ? ((R & ~31) + perm32(R & 31)) : R;
        voffA[i] = (unsigned)(R * K + C) * 2u; voffB[i] = (unsigned)(Rb * K + C) * 2u; }
    const size_t kstep = (size_t)(BK * 2);
    const size_t hstep = (size_t)HALF * K * 2;
    const size_t tstep = 2 * hstep;
    const unsigned ldsw = (unsigned)wid * 1024u;
    const int aoff = lds_byte(wr * 64 + fr, fq * 8), boff = lds_byte(wc * 32 + fr, fq * 8);
#define PG8_SA(b, h) (((b) * 2 + (h)) * HTB)
#define PG8_SB(b, h) ((4 + (b) * 2 + (h)) * HTB)
#define PG8_STAGE(bufoff, gbase, voff) do { _Pragma("unroll") for (int _i = 0; _i < 2; ++_i) \
        __builtin_amdgcn_global_load_lds((const unsigned*)((const char*)(gbase) + (voff)[_i]), (PG8_LAS unsigned*)(lds + (bufoff) + ldsw + _i * 8192), 16, 0, 0); } while (0)
#define PG8_LDA(dst, b, h) do { _Pragma("unroll") for (int m = 0; m < 4; ++m) _Pragma("unroll") for (int k = 0; k < 2; ++k) dst[m][k] = *(const PG8_LAS bf16x8*)(lds + PG8_SA(b, h) + aoff + m * 2048 + k * 1024); } while (0)
#define PG8_LDB(dst, b, h) do { _Pragma("unroll") for (int n = 0; n < 2; ++n) _Pragma("unroll") for (int k = 0; k < 2; ++k) dst[n][k] = *(const PG8_LAS bf16x8*)(lds + PG8_SB(b, h) + boff + n * 2048 + k * 1024); } while (0)
#define PG8_MMA(ai, bj, At, Bt) do { __builtin_amdgcn_s_setprio(1); _Pragma("unroll") for (int m = 0; m < 4; ++m) _Pragma("unroll") for (int n = 0; n < 2; ++n) _Pragma("unroll") for (int k = 0; k < 2; ++k) \
        acc[ai][bj][m][n] = __builtin_amdgcn_mfma_f32_16x16x32_bf16(Bt[n][k], At[m][k], acc[ai][bj][m][n], 0, 0, 0); __builtin_amdgcn_s_setprio(0); } while (0)
#define PG8_WAIT_V(n) asm volatile("s_waitcnt vmcnt(" #n ")" ::: "memory")
#define PG8_WAIT_L(n) asm volatile("s_waitcnt lgkmcnt(" #n ")" ::: "memory")
#define PG8_BAR __builtin_amdgcn_s_barrier()
#define PG8_SCHED __builtin_amdgcn_sched_barrier(0)
    Unit cur, nxt; int ui = 0;
    if (!S.next(0, cur)) return;
    f32x4 acc[2][2][4][2];
#pragma unroll
    for (int a = 0; a < 2; ++a)
#pragma unroll
        for (int b = 0; b < 2; ++b)
#pragma unroll
            for (int m = 0; m < 4; ++m)
#pragma unroll
                for (int n = 0; n < 2; ++n) acc[a][b][m][n] = (f32x4){0.f, 0.f, 0.f, 0.f};
    bf16x8 At[4][2], B0[2][2], B1[2][2];
    const char* cA = (const char*)g.A + (size_t)cur.pm * tstep; const char* cB = (const char*)g.Bt + (size_t)cur.pn * tstep;
    S.a_ready(cur);
    if constexpr (SP2) {
        PG8_STAGE(PG8_SB(0, 0), cB, voffB); PG8_STAGE(PG8_SB(0, 1), cB + hstep, voffB); PG8_STAGE(PG8_SA(0, 0), cA, voffA); PG8_STAGE(PG8_SA(0, 1), cA + hstep, voffA);
        if (wr == 1) PG8_BAR;
        PG8_WAIT_V(2); PG8_BAR;
        PG8_STAGE(PG8_SB(1, 0), cB + kstep, voffB); PG8_STAGE(PG8_SA(1, 0), cA + kstep, voffA); PG8_STAGE(PG8_SB(1, 1), cB + hstep + kstep, voffB);
        PG8_WAIT_V(6); PG8_BAR;
    } else {
        PG8_STAGE(PG8_SB(0, 0), cB, voffB); PG8_STAGE(PG8_SA(0, 0), cA, voffA); PG8_STAGE(PG8_SB(0, 1), cB + hstep, voffB); PG8_STAGE(PG8_SA(0, 1), cA + hstep, voffA);
        if (wr == 1) PG8_BAR;
        PG8_WAIT_V(4); PG8_BAR;
        PG8_STAGE(PG8_SB(1, 0), cB + kstep, voffB); PG8_STAGE(PG8_SA(1, 0), cA + kstep, voffA); PG8_STAGE(PG8_SB(1, 1), cB + hstep + kstep, voffB);
        PG8_WAIT_V(6); PG8_BAR;
    }
    for (;;) {
        const bool has_next = S.next(ui + 1, nxt);
        const char* nA = has_next ? (const char*)g.A + (size_t)nxt.pm * tstep : cA; const char* nB = has_next ? (const char*)g.Bt + (size_t)nxt.pn * tstep : cB;
        for (int t = 0; t < nt; t += 2) {
            const bool last = (t == nt - 2);
            const char* a1 = cA + (size_t)(t + 1) * kstep;
            const char* a2 = last ? nA : cA + (size_t)(t + 2) * kstep; const char* b2 = last ? nB : cB + (size_t)(t + 2) * kstep;
            const char* a3 = a2 + kstep; const char* b3 = b2 + kstep;
            if (last && has_next) S.a_ready(nxt);
            if constexpr (SP2) {
            PG8_LDB(B0, 0, 0); PG8_LDB(B1, 0, 1); PG8_SCHED; PG8_LDA(At, 0, 0); PG8_STAGE(PG8_SA(1, 1), a1 + hstep, voffA);
            PG8_WAIT_V(8); PG8_WAIT_L(0); PG8_BAR; PG8_MMA(0, 0, At, B0); PG8_MMA(0, 1, At, B1); PG8_BAR; PG8_SCHED;
            PG8_LDA(At, 0, 1); PG8_STAGE(PG8_SB(0, 0), b2, voffB); PG8_STAGE(PG8_SB(0, 1), b2 + hstep, voffB); PG8_STAGE(PG8_SA(0, 0), a2, voffA);
            PG8_WAIT_V(8); PG8_WAIT_L(0); PG8_BAR; PG8_MMA(1, 0, At, B0); PG8_MMA(1, 1, At, B1); PG8_BAR; PG8_SCHED;
            PG8_LDB(B0, 1, 0); PG8_LDB(B1, 1, 1); PG8_SCHED; PG8_LDA(At, 1, 0); PG8_STAGE(PG8_SA(0, 1), a2 + hstep, voffA);
            PG8_WAIT_V(8); PG8_WAIT_L(0); PG8_BAR; PG8_MMA(0, 0, At, B0); PG8_MMA(0, 1, At, B1); PG8_BAR; PG8_SCHED;
            PG8_LDA(At, 1, 1); PG8_STAGE(PG8_SB(1, 0), b3, voffB); PG8_STAGE(PG8_SB(1, 1), b3 + hstep, voffB); PG8_STAGE(PG8_SA(1, 0), a3, voffA);
            PG8_WAIT_V(8); PG8_WAIT_L(0); PG8_BAR; PG8_MMA(1, 0, At, B0); PG8_MMA(1, 1, At, B1); PG8_BAR; PG8_SCHED;
            } else {
            PG8_LDB(B0, 0, 0); PG8_SCHED; PG8_LDA(At, 0, 0); PG8_STAGE(PG8_SA(1, 1), a1 + hstep, voffA);
            PG8_WAIT_L(8); PG8_BAR; PG8_WAIT_L(0); PG8_MMA(0, 0, At, B0); PG8_BAR; PG8_SCHED;
            PG8_LDB(B1, 0, 1); PG8_STAGE(PG8_SB(0, 0), b2, voffB);
            PG8_BAR; PG8_WAIT_L(0); PG8_MMA(0, 1, At, B1); PG8_BAR;
            PG8_LDA(At, 0, 1); PG8_STAGE(PG8_SA(0, 0), a2, voffA);
            PG8_BAR; PG8_WAIT_L(0); PG8_MMA(1, 0, At, B0); PG8_BAR; PG8_SCHED;
            PG8_STAGE(PG8_SB(0, 1), b2 + hstep, voffB);
            PG8_WAIT_V(6); PG8_BAR; PG8_MMA(1, 1, At, B1); PG8_BAR;
            PG8_LDB(B0, 1, 0); PG8_SCHED; PG8_LDA(At, 1, 0); PG8_STAGE(PG8_SA(0, 1), a2 + hstep, voffA);
            PG8_WAIT_L(8); PG8_BAR; PG8_WAIT_L(0); PG8_MMA(0, 0, At, B0); PG8_BAR; PG8_SCHED;
            PG8_LDB(B1, 1, 1); PG8_STAGE(PG8_SB(1, 0), b3, voffB);
            PG8_BAR; PG8_WAIT_L(0); PG8_MMA(0, 1, At, B1); PG8_BAR;
            PG8_LDA(At, 1, 1); PG8_STAGE(PG8_SA(1, 0), a3, voffA);
            PG8_BAR; PG8_WAIT_L(0); PG8_MMA(1, 0, At, B0); PG8_BAR; PG8_SCHED;
            PG8_STAGE(PG8_SB(1, 1), b3 + hstep, voffB);
            PG8_WAIT_V(6); PG8_BAR; PG8_MMA(1, 1, At, B1); PG8_BAR;
            }
        }
        if constexpr (ALIGN_EPI) { if (wr == 0) PG8_BAR; }
        if constexpr (!Epi::AFTER_DRAIN) { E(acc, cur, wr, wc, fr, fq); S.done(cur); }
        if (!has_next) break;
#pragma unroll
        for (int a = 0; a < 2; ++a)
#pragma unroll
            for (int b = 0; b < 2; ++b)
#pragma unroll
                for (int m = 0; m < 4; ++m)
#pragma unroll
                    for (int n = 0; n < 2; ++n) acc[a][b][m][n] = (f32x4){0.f, 0.f, 0.f, 0.f};
        cur = nxt; cA = nA; cB = nB; ++ui;
        if constexpr (ALIGN_EPI) { if (wr == 1) PG8_BAR; }
    }
    PG8_WAIT_V(0);
    if constexpr (!ALIGN_EPI) { if (wr == 0) PG8_BAR; }
    PG8_BAR;
    if constexpr (Epi::AFTER_DRAIN) { E.fused(acc, cur, wr, wc, fr, fq, lds, wid, lane); S.done(cur); }
#undef PG8_SA
#undef PG8_SB
#undef PG8_STAGE
#undef PG8_LDA
#undef PG8_LDB
#undef PG8_MMA
#undef PG8_WAIT_V
#undef PG8_WAIT_L
#undef PG8_BAR
#undef PG8_SCHED
}

template <class Epi, bool G1>
__device__ __forceinline__ void moe_gemm(PG8_LAS unsigned char* lds, const bf16_t* Abase, const int* tsi, const float* W0, const float* W1, const PG8_LAS int* offs, const PG8_LAS int* cnts,
                                         const GroupedOrder& S, const Epi& E, int wave_in) {
    constexpr int K = G1 ? 2048 : 1024, NT = K / BK, LDW = G1 ? 1024 : 2048;
    const int wid = __builtin_amdgcn_readfirstlane(wave_in), lane = lane_id(), tid = wid * 64 + lane, wr = wid >> 2, wc = wid & 3, fr = lane & 15, fq = lane >> 4;
    int RA[2], CA[2];
#pragma unroll
    for (int i = 0; i < 2; ++i) stage_rc(tid * 16 + i * 8192, RA[i], CA[i]);
    const unsigned ldsw = (unsigned)wid * 1024u;
    const int aoff = lds_byte(wr * 64 + fr, fq * 8), boff = lds_byte(wc * 32 + fr, fq * 8);
    const int hfB = wid >> 2, kgB = (tid >> 5) & 7, ngB = tid & 31, g8 = ngB & 7;
    const int wB0 = lds_byte(32 * (ngB >> 3) + (g8 & 1) * 16 + (g8 >> 1) * 4, 8 * kgB);
#define MG_WACT(u) ((u).sub < 0 || ((u).sub < 4 ? wc == (u).sub : (wc >> 1) == (u).sub - 4))
#define MG_BACT(u) ((u).sub < 0 || ((u).sub < 4 ? (ngB >> 3) == (u).sub : (ngB >> 4) == (u).sub - 4))
#define MG_SA(b, h) (((b) * 2 + (h)) * HTB)
#define MG_SB(b, h) ((4 + (b) * 2 + (h)) * HTB)
#define MG_ROWS(u, dst) do { const int e_ = (u).pn >> 3, lim_ = offs[e_] + cnts[e_]; _Pragma("unroll") for (int h_ = 0; h_ < 2; ++h_) _Pragma("unroll") for (int i_ = 0; i_ < 2; ++i_) { \
        const int p_ = (u).pm * 256 + h_ * 128 + RA[i_]; const int row_ = G1 ? ((p_ < lim_ ? tsi[e_ * 16384 + p_ - offs[e_]] : 0) >> 1) : p_; dst[h_][i_] = p_ < lim_ ? (unsigned)row_ * (unsigned)(K * 2) + (unsigned)(CA[i_] * 2) : 0xffffffffu; } } while (0)
#define MG_BPTR(u) (G1 ? ((hfB ? W1 : W0) + (size_t)((u).pn >> 3) * 2048 * 1024 + 128 * ((u).pn & 7) + 4 * ngB + (size_t)(8 * kgB) * LDW) \
                       : (W0 + (size_t)((u).pn >> 3) * 1024 * 2048 + 256 * ((u).pn & 7) + 128 * hfB + 4 * ngB + (size_t)(8 * kgB) * LDW))
#define MG_STAGE_A(b, rows, k0) do { _Pragma("unroll") for (int h_ = 0; h_ < 2; ++h_) _Pragma("unroll") for (int i_ = 0; i_ < 2; ++i_) if (rows[h_][i_] != 0xffffffffu) \
        __builtin_amdgcn_global_load_lds((const unsigned*)((const char*)Abase + rows[h_][i_] + (k0) * 2), (PG8_LAS unsigned*)(lds + MG_SA(b, h_) + ldsw + i_ * 8192), 16, 0, 0); } while (0)
#define MG_LOAD_B(ptr, k0) do { _Pragma("unroll") for (int j_ = 0; j_ < 8; ++j_) bv[j_] = *(const f32x4*)((ptr) + (size_t)((k0) + j_) * LDW); } while (0)
#define MG_WRITE_B(b) do { _Pragma("unroll") for (int c_ = 0; c_ < 4; ++c_) { u32x4 w_; w_.x = cvt_pk_bf16(bv[0][c_], bv[1][c_]); w_.y = cvt_pk_bf16(bv[2][c_], bv[3][c_]); w_.z = cvt_pk_bf16(bv[4][c_], bv[5][c_]); w_.w = cvt_pk_bf16(bv[6][c_], bv[7][c_]); \
        *(PG8_LAS u32x4*)(lds + MG_SB(b, hfB) + wB0 + 64 * c_) = w_; } } while (0)
#define MG_LDA(dst, b, h, mp) do { _Pragma("unroll") for (int m = 0; m < 2; ++m) _Pragma("unroll") for (int k = 0; k < 2; ++k) dst[m][k] = *(const PG8_LAS bf16x8*)(lds + MG_SA(b, h) + aoff + (2 * (mp) + m) * 2048 + k * 1024); } while (0)
#define MG_LDB(dst, b, h) do { _Pragma("unroll") for (int n = 0; n < 2; ++n) _Pragma("unroll") for (int k = 0; k < 2; ++k) dst[n][k] = *(const PG8_LAS bf16x8*)(lds + MG_SB(b, h) + boff + n * 2048 + k * 1024); } while (0)
#define MG_MMA(ai, bj, mp, At, Bt) do { _Pragma("unroll") for (int m = 0; m < 2; ++m) _Pragma("unroll") for (int n = 0; n < 2; ++n) _Pragma("unroll") for (int k = 0; k < 2; ++k) \
        acc[ai][bj][2 * (mp) + m][n] = __builtin_amdgcn_mfma_f32_16x16x32_bf16(Bt[n][k], At[m][k], acc[ai][bj][2 * (mp) + m][n], 0, 0, 0); } while (0)
#define MG_SYNC() do { asm volatile("s_waitcnt vmcnt(0) lgkmcnt(0)" ::: "memory"); __builtin_amdgcn_s_barrier(); asm volatile("" ::: "memory"); } while (0)
    Unit cur, nxt; int ui = 0;
    if (!S.next(0, cur)) return;
    f32x4 acc[2][2][4][2];
#pragma unroll
    for (int a = 0; a < 2; ++a)
#pragma unroll
        for (int b = 0; b < 2; ++b)
#pragma unroll
            for (int m = 0; m < 4; ++m)
#pragma unroll
                for (int n = 0; n < 2; ++n) acc[a][b][m][n] = (f32x4){0.f, 0.f, 0.f, 0.f};
    bf16x8 At[2][2], B0[2][2], B1[2][2];
    f32x4 bv[8];
    unsigned rowC[2][2];
    MG_ROWS(cur, rowC); const float* bC = MG_BPTR(cur); bool bact = MG_BACT(cur);
    MG_STAGE_A(0, rowC, 0); if (bact) { MG_LOAD_B(bC, 0); MG_WRITE_B(0); }
    bool bactP = bact;
    if (bact) MG_LOAD_B(bC, BK);
    asm volatile("s_waitcnt vmcnt(8) lgkmcnt(0)" ::: "memory"); __builtin_amdgcn_s_barrier(); asm volatile("" ::: "memory");
    int buf = 0;
    for (;;) {
        const bool has_next = S.next(ui + 1, nxt);
        const bool wact = MG_WACT(cur);
        for (int t = 0; t < NT; ++t) {
            const bool last = (t == NT - 1), more = !last || has_next;
            if (wact) { MG_LDB(B0, buf, 0); MG_LDB(B1, buf, 1); }
            if (!last) { MG_STAGE_A(buf ^ 1, rowC, (t + 1) * BK); }
            else if (has_next) { MG_ROWS(nxt, rowC); MG_STAGE_A(buf ^ 1, rowC, 0); }
            if (wact) {
#pragma unroll
              for (int ai = 0; ai < 2; ++ai)
#pragma unroll
                for (int mp = 0; mp < 2; ++mp) { MG_LDA(At, buf, ai, mp); MG_MMA(ai, 0, mp, At, B0); MG_MMA(ai, 1, mp, At, B1); } }
            if (more && bactP) MG_WRITE_B(buf ^ 1);
            bool issued = false;
            if (t + 2 < NT) { if (bact) MG_LOAD_B(bC, (t + 2) * BK); issued = true; }
            else if (has_next) { if (t + 2 == NT) { bC = MG_BPTR(nxt); bact = MG_BACT(nxt); } if (bact) MG_LOAD_B(bC, (t + 2 - NT) * BK); issued = true; }
            bactP = bact;
            if (issued) { asm volatile("s_waitcnt vmcnt(8) lgkmcnt(0)" ::: "memory"); } else { asm volatile("s_waitcnt vmcnt(0) lgkmcnt(0)" ::: "memory"); }
            __builtin_amdgcn_s_barrier(); asm volatile("" ::: "memory");
            buf ^= 1;
        }
        if (wact) E(acc, cur, wr, wc, fr, fq);
        if (!has_next) break;
#pragma unroll
        for (int a = 0; a < 2; ++a)
#pragma unroll
            for (int b = 0; b < 2; ++b)
#pragma unroll
                for (int m = 0; m < 4; ++m)
#pragma unroll
                    for (int n = 0; n < 2; ++n) acc[a][b][m][n] = (f32x4){0.f, 0.f, 0.f, 0.f};
        cur = nxt; ++ui;
    }
#undef MG_SA
#undef MG_WACT
#undef MG_BACT
#undef MG_SB
#undef MG_ROWS
#undef MG_BPTR
#undef MG_STAGE_A
#undef MG_LOAD_B
#undef MG_WRITE_B
#undef MG_LDA
#undef MG_LDB
#undef MG_MMA
#undef MG_SYNC
}
}

__device__ __forceinline__ float wave_sum(float v) {
#pragma unroll
    for (int o = 32; o >= 1; o >>= 1) v += __shfl_xor(v, o);
    return v;
}
__device__ __forceinline__ float wave_max(float v) {
#pragma unroll
    for (int o = 32; o >= 1; o >>= 1) v = fmaxf(v, __shfl_xor(v, o));
    return v;
}
__device__ __forceinline__ unsigned f2bf(float f) { unsigned u = __builtin_bit_cast(unsigned, f); return (u + 0x7fffu + ((u >> 16) & 1u)) >> 16; }
__device__ __forceinline__ unsigned pk2(float lo, float hi) { return f2bf(lo) | (f2bf(hi) << 16); }
typedef unsigned short bf16;
typedef unsigned u32x4 __attribute__((ext_vector_type(4)));
typedef unsigned u32x2 __attribute__((ext_vector_type(2)));
__device__ __forceinline__ float bf_lo(unsigned u) { return __builtin_bit_cast(float, u << 16); }
__device__ __forceinline__ float bf_hi(unsigned u) { return __builtin_bit_cast(float, u & 0xffff0000u); }
__device__ __forceinline__ float sigm(float x) { return 1.f / (1.f + expf(-x)); }
__device__ __forceinline__ float silu(float x) { return x / (1.f + expf(-x)); }
__device__ __forceinline__ int rel_bucket(int n) {
    if (n < 16) return n < 0 ? 0 : n;
    if (n >= 113) return 31;
    if (n <= 18) return 16; if (n <= 20) return 17; if (n <= 23) return 18; if (n <= 26) return 19; if (n <= 30) return 20; if (n <= 34) return 21;
    if (n <= 39) return 22; if (n <= 45) return 23; if (n <= 51) return 24; if (n <= 58) return 25; if (n <= 66) return 26; if (n <= 76) return 27;
    if (n <= 86) return 28; if (n <= 98) return 29; return 30;
}

struct Frame {
    LAS unsigned char* lds; int tid, lane, wave, gw, NGW, gtid, NT;
    const float *i_x, *i_norm1_g, *i_w_in, *i_lbl, *i_hg_norm_g, *i_pe_k, *i_w1_k, *i_w2_k, *i_pe_v, *i_w1_v, *i_w2_v, *i_rel_bias, *i_w_out, *i_norm2_g, *i_wrg, *i_brg, *i_wre, *i_bre, *i_weg, *i_weu, *i_wed, *i_final_g; float* out; unsigned char* ws;
    template <class Tp> __device__ __forceinline__ Tp* w(size_t off) const { return (Tp*)(ws + off); }
};

#define CAS __attribute__((address_space(4)))
__device__ __forceinline__ Frame relocal(int wave) {
    const CAS Args* ap = (const CAS Args*)__builtin_amdgcn_kernarg_segment_ptr();
    asm volatile("" : "+s"(ap)); asm volatile("" : "+s"(wave));
    Frame F; extern __shared__ __attribute__((aligned(16))) unsigned char lds_raw[];
    F.lds = (LAS unsigned char*)lds_raw;
    const int ln = (int)__builtin_amdgcn_mbcnt_hi(~0u, __builtin_amdgcn_mbcnt_lo(~0u, 0u));
    F.wave = wave; F.lane = ln; F.tid = wave * 64 + ln;
    F.gw = blockIdx.x * 8 + wave; F.NGW = gridDim.x * 8; F.gtid = blockIdx.x * NTHR + F.tid; F.NT = gridDim.x * NTHR;
    F.i_x = ap->in[0]; F.i_norm1_g = ap->in[1]; F.i_w_in = ap->in[2]; F.i_lbl = ap->in[3]; F.i_hg_norm_g = ap->in[4]; F.i_pe_k = ap->in[5]; F.i_w1_k = ap->in[6]; F.i_w2_k = ap->in[7]; F.i_pe_v = ap->in[8]; F.i_w1_v = ap->in[9]; F.i_w2_v = ap->in[10]; F.i_rel_bias = ap->in[11]; F.i_w_out = ap->in[12]; F.i_norm2_g = ap->in[13]; F.i_wrg = ap->in[14]; F.i_brg = ap->in[15]; F.i_wre = ap->in[16]; F.i_bre = ap->in[17]; F.i_weg = ap->in[18]; F.i_weu = ap->in[19]; F.i_wed = ap->in[20]; F.i_final_g = ap->in[21];
    F.out = ap->out; F.ws = ap->ws;
    return F;
}
__device__ __forceinline__ void transpose_item(const float* W, int K, int ldw, int nvalid, int k0, int n0, bf16* WT, int drow0, LAS float* scr, int lane, bool frag = false) {
    const int rsub = lane >> 3, c4 = lane & 7; const bool ok = n0 + 4 * c4 < nvalid;
    f32x4 v[8];
#pragma unroll
    for (int i = 0; i < 8; ++i) v[i] = ok ? __builtin_nontemporal_load((const f32x4*)(W + (size_t)(k0 + 8 * i + rsub) * ldw + n0 + 4 * c4)) : (f32x4){0.f, 0.f, 0.f, 0.f};
#pragma unroll
    for (int i = 0; i < 8; ++i) { LAS float* d = scr + (8 * i + rsub) * 33 + 4 * c4; d[0] = v[i][0]; d[1] = v[i][1]; d[2] = v[i][2]; d[3] = v[i][3]; }
    asm volatile("s_waitcnt lgkmcnt(0)" ::: "memory");
    const int c = lane & 7;
#pragma unroll
    for (int j = 0; j < 4; ++j) { const int n = (lane >> 3) + 8 * j; const LAS float* sp = scr + (8 * c) * 33 + n;
        u32x4 o; o.x = pk2(sp[0 * 33], sp[1 * 33]); o.y = pk2(sp[2 * 33], sp[3 * 33]); o.z = pk2(sp[4 * 33], sp[5 * 33]); o.w = pk2(sp[6 * 33], sp[7 * 33]);
        const int kk = k0 + 8 * c, nr = drow0 + n;
        bf16* dst = frag ? WT + ((size_t)(((nr >> 5) * (K >> 4) + (kk >> 4)) * 64 + ((kk >> 3) & 1) * 32 + (nr & 31))) * 8 : WT + (size_t)nr * K + kk;
        __builtin_nontemporal_store(o, (u32x4*)dst); }
    asm volatile("s_waitcnt lgkmcnt(0)" ::: "memory");
}
__device__ __forceinline__ void ph_prologue(const Frame& F) {
    const float* x = F.i_x; const float* g1 = F.i_norm1_g; bf16* HB = F.w<bf16>(WS_HB);
    { f32x4 v[8], vn[8];
      float4 gw[8];
#pragma unroll
      for (int j = 0; j < 8; ++j) gw[j] = ((const float4*)g1)[F.lane + 64 * j];
      int m = F.gw;
      if (m < T) { const f32x4* xr = (const f32x4*)(x + (size_t)m * D);
#pragma unroll
          for (int j = 0; j < 8; ++j) v[j] = __builtin_nontemporal_load(xr + F.lane + 64 * j); }
      for (; m < T; m += F.NGW) {
          const int mn = m + F.NGW;
          if (mn < T) { const f32x4* xn = (const f32x4*)(x + (size_t)mn * D);
#pragma unroll
              for (int j = 0; j < 8; ++j) vn[j] = __builtin_nontemporal_load(xn + F.lane + 64 * j); }
          float ss = 0.f;
#pragma unroll
          for (int j = 0; j < 8; ++j) ss += v[j].x * v[j].x + v[j].y * v[j].y + v[j].z * v[j].z + v[j].w * v[j].w;
          const float r = rsqrtf(wave_sum(ss) * (1.f / D) + EPS);
          u32x2* hr = (u32x2*)(HB + (size_t)m * D);
#pragma unroll
          for (int j = 0; j < 8; ++j) { const float4 g = gw[j]; u32x2 o; o.x = pk2(v[j].x * r * g.x, v[j].y * r * g.y); o.y = pk2(v[j].z * r * g.z, v[j].w * r * g.w); hr[F.lane + 64 * j] = o; }
#pragma unroll
          for (int j = 0; j < 8; ++j) v[j] = vn[j];
      } }
    const float* lbl = F.i_lbl; float* LB = F.w<float>(WS_LB);
    for (int i = F.gtid; i < 1024; i += F.NT) { const float l0 = lbl[i], l1 = lbl[1024 + i], m = fmaxf(l0, l1), e0 = expf(l0 - m), e1 = expf(l1 - m); LB[i] = e0 / (e0 + e1); }
    const float* wrg = F.i_wrg; const float* brg = F.i_brg; const float* wre = F.i_wre; const float* bre = F.i_bre;
    bf16* WRT = F.w<bf16>(WS_WRT); float* BR = F.w<float>(WS_BR);
    for (int i = F.gtid; i < 96 * 2048; i += F.NT) { const int n = i >> 11, k = i & 2047;
        WRT[((((n >> 5) * 128 + (k >> 4)) * 64 + ((k >> 3) & 1) * 32 + (n & 31)) << 3) + (k & 7)] = (bf16)f2bf(n < 8 ? wrg[k * 8 + n] : (n < 72 ? wre[k * 64 + (n - 8)] : 0.f)); }
    for (int c = F.gtid; c < 128; c += F.NT) BR[c] = c < 8 ? brg[c] : (c < 72 ? bre[c - 8] : 0.f);
    LAS float* scr = (LAS float*)(F.lds + F.wave * 16384);
    constexpr int I_IN = (D / 64) * (LDP / 32), I_OUT = (D / 64) * (D / 32), I_W1 = 32 * 8, I_W2 = 4 * 2;
    for (int it = F.gw; it < I_IN + I_OUT + 2 * I_W1 + 2 * I_W2; it += F.NGW) {
        if (it < I_IN) { const int kb = it / (LDP / 32), nb = it % (LDP / 32); transpose_item(F.i_w_in, D, WIN_N, WIN_N, 64 * kb, 32 * nb, F.w<bf16>(WS_WINT), 32 * nb, scr, F.lane); }
        else if (it < I_IN + I_OUT) { const int r = it - I_IN, kb = r / (D / 32), nb = r % (D / 32); transpose_item(F.i_w_out, D, D, D, 64 * kb, 32 * nb, F.w<bf16>(WS_WOUTT), 32 * nb, scr, F.lane); }
        else if (it < I_IN + I_OUT + 2 * I_W1) { const int r = it - I_IN - I_OUT, which = r / I_W1, q = r % I_W1, kb = q >> 3, nb = q & 7;
            transpose_item(which ? F.i_w1_v : F.i_w1_k, 2048, 256, 256, 64 * kb, 32 * nb, F.w<bf16>(WS_W1T) + (size_t)which * 256 * 2048, 32 * nb, scr, F.lane, true); }
        else { const int r = it - I_IN - I_OUT - 2 * I_W1, which = r / I_W2, q = r % I_W2, kb = q >> 1, nb = q & 1;
            transpose_item(which ? F.i_w2_v : F.i_w2_k, 256, 64, 64, 64 * kb, 32 * nb, F.w<bf16>(WS_W2T) + (size_t)which * 64 * 256, 32 * nb, scr, F.lane); }
    }
}

__device__ __forceinline__ void ph_inproj(const Frame& F) {
    pg8::Gemm g{F.w<bf16>(WS_HB), F.w<bf16>(WS_WINT), T, LDP, D}; pg8::StaticOrder So; So.init(T, LDP, (int)gridDim.x, (int)blockIdx.x);
    pg8::EpiProj E{F.w<bf16>(WS_QH), F.w<bf16>(WS_VH), F.w<bf16>(WS_GH), F.w<bf16>(WS_QN), F.w<bf16>(WS_KV6), F.w<bf16>(WS_LOGF), F.w<float>(WS_GATE), F.w<float>(WS_LB)};
    pg8::gemm_phase<pg8::EpiProj, pg8::StaticOrder, true, true>(F.lds, g, So, E, F.wave);
}

namespace nsa {
typedef float f32x16 __attribute__((ext_vector_type(16)));
typedef short s16x8 __attribute__((ext_vector_type(8)));
typedef short s16x4 __attribute__((ext_vector_type(4)));
typedef float f32x2v __attribute__((ext_vector_type(2)));
typedef __bf16 bf16x2v __attribute__((ext_vector_type(2)));
#define NSA_MFMA(a, b, c) __builtin_amdgcn_mfma_f32_32x32x16_bf16((a), (b), (c), 0, 0, 0)
#define NDI __device__ __forceinline__
constexpr int KP = 144, VP = 144, VCP = 528;
constexpr int L_KS = 0, L_VT = 18432, L_KC = 0, L_VCT = 36864, L_BIAS = 70656, L_STAT = 74752, L_IMPA = 76800, L_IMPB = 93184, L_SEL = 109568;
constexpr float NEG = -1e30f, LOG2E = 1.4426950408889634f;

NDI unsigned pkbf(float a, float b) { return __builtin_bit_cast(unsigned, __builtin_convertvector(((f32x2v){a, b}), bf16x2v)); }
NDI float hmax32(float v) { auto rr = __builtin_amdgcn_permlane32_swap(__float_as_uint(v), __float_as_uint(v), false, false); return fmaxf(__uint_as_float(rr[0]), __uint_as_float(rr[1])); }
NDI float hsum32(float v) { auto rr = __builtin_amdgcn_permlane32_swap(__float_as_uint(v), __float_as_uint(v), false, false); return __uint_as_float(rr[0]) + __uint_as_float(rr[1]); }

NDI void st_block(f32x16 (&Sv)[2], const LAS char* ks, const s16x8 (&Qf)[4], int r, int h) {
    f32x16 a0, a1;
#pragma unroll
    for (int i = 0; i < 16; ++i) { a0[i] = 0.f; a1[i] = 0.f; }
    s16x8 k0[4], k1[4];
#pragma unroll
    for (int s = 0; s < 4; ++s) { k0[s] = *(const LAS s16x8*)(ks + r * KP + 32 * s + 16 * h); k1[s] = *(const LAS s16x8*)(ks + (32 + r) * KP + 32 * s + 16 * h); }
#pragma unroll
    for (int s = 0; s < 4; ++s) { a0 = NSA_MFMA(k0[s], Qf[s], a0); a1 = NSA_MFMA(k1[s], Qf[s], a1); }
    Sv[0] = a0; Sv[1] = a1;
}
NDI void pv_block(const f32x16 (&P)[2], f32x16 (&O)[2], const LAS char* vt, int pitch, int r, int h) {
#pragma unroll
    for (int t = 0; t < 2; ++t)
#pragma unroll
        for (int sp = 0; sp < 2; ++sp) {
            u32x4 w; w.x = pkbf(P[t][8 * sp + 0], P[t][8 * sp + 1]); w.y = pkbf(P[t][8 * sp + 2], P[t][8 * sp + 3]); w.z = pkbf(P[t][8 * sp + 4], P[t][8 * sp + 5]); w.w = pkbf(P[t][8 * sp + 6], P[t][8 * sp + 7]);
            const s16x8 pf = __builtin_bit_cast(s16x8, w);
#pragma unroll
            for (int dt = 0; dt < 2; ++dt) { const LAS char* a = vt + (32 * dt + r) * pitch + (32 * t + 16 * sp + 4 * h) * 2;
                const s16x4 lo = *(const LAS s16x4*)a, hi = *(const LAS s16x4*)(a + 16);
                const s16x8 af = __builtin_shufflevector(lo, hi, 0, 1, 2, 3, 4, 5, 6, 7);
                O[dt] = NSA_MFMA(af, pf, O[dt]); } }
}
template <int MASK, int BIAS>
NDI void bias_mask(f32x16 (&Sv)[2], const LAS float* btab, int bj0, int lim) {
#pragma unroll
    for (int t = 0; t < 2; ++t) {
        float bb[16];
        if (BIAS != 0) {
#pragma unroll
            for (int i = 0; i < 16; ++i) { const int kc = 32 * t + (i & 3) + 8 * (i >> 2);
                if (BIAS == 1) bb[i] = btab[kc]; else { int j = bj0 + 16 * kc; j = j < 0 ? 0 : (j > 255 ? 255 : j); bb[i] = btab[j]; } }
            asm volatile("s_waitcnt lgkmcnt(0)" ::: "memory"); }
#pragma unroll
        for (int i = 0; i < 16; ++i) { const int kc = 32 * t + (i & 3) + 8 * (i >> 2);
            float s = Sv[t][i];
            if (BIAS != 0) s += bb[i];
            if (MASK == 1) s = (kc <= lim) ? s : NEG; else if (MASK == 2) s = (kc > lim) ? s : NEG; else if (MASK == 3) s = (kc < lim) ? s : NEG;
            Sv[t][i] = s; } }
}
NDI void softmax_core(f32x16 (&Sv)[2], float& m, float& lsum, f32x16 (&O)[2], bool rowactive) {
    float bm = NEG;
#pragma unroll
    for (int t = 0; t < 2; ++t)
#pragma unroll
        for (int i = 0; i < 16; ++i) bm = fmaxf(bm, Sv[t][i]);
    bm = hmax32(bm); if (!rowactive) bm = NEG;
    const float mn = fmaxf(m, bm), alpha = __builtin_amdgcn_exp2f(m - mn), msel = (rowactive && mn > -1e29f) ? mn : 1e30f; m = mn;
    float ps = 0.f;
#pragma unroll
    for (int t = 0; t < 2; ++t)
#pragma unroll
        for (int i = 0; i < 16; ++i) { const float p = __builtin_amdgcn_exp2f(Sv[t][i] - msel); Sv[t][i] = p; ps += p; }
    lsum = lsum * alpha + ps;
    if (__builtin_amdgcn_ballot_w64(alpha != 1.f) != 0ull) {
#pragma unroll
        for (int dt = 0; dt < 2; ++dt)
#pragma unroll
            for (int i = 0; i < 16; ++i) O[dt][i] *= alpha; }
}
#define NSA_MX3(a, b, c) __builtin_fmaxf(__builtin_fmaxf((a), (b)), (c))
NDI float rowmax2(const f32x16& p0, const f32x16& p1) {
    float a = NSA_MX3(p0[0], p0[1], p1[0]), b = NSA_MX3(p0[2], p0[3], p1[1]); a = NSA_MX3(a, p1[2], p1[3]);
#pragma unroll
    for (int r = 4; r < 16; r += 4) { a = NSA_MX3(a, p0[r], p0[r + 1]); b = NSA_MX3(b, p0[r + 2], p0[r + 3]); a = NSA_MX3(a, p1[r], p1[r + 1]); b = NSA_MX3(b, p1[r + 2], p1[r + 3]); }
    return hmax32(__builtin_fmaxf(a, b)); }
NDI void st_block_c(f32x16 (&Sv)[2], const LAS char* ks, const s16x8 (&Qf)[4], int r, int h, const f32x16& cinit) {
    f32x16 a0, a1; s16x8 k0[4], k1[4];
#pragma unroll
    for (int s = 0; s < 4; ++s) { k0[s] = *(const LAS s16x8*)(ks + r * KP + 32 * s + 16 * h); k1[s] = *(const LAS s16x8*)(ks + (32 + r) * KP + 32 * s + 16 * h); }
    a0 = NSA_MFMA(k0[0], Qf[0], cinit); a1 = NSA_MFMA(k1[0], Qf[0], cinit);
#pragma unroll
    for (int s = 1; s < 4; ++s) { a0 = NSA_MFMA(k0[s], Qf[s], a0); a1 = NSA_MFMA(k1[s], Qf[s], a1); }
    Sv[0] = a0; Sv[1] = a1;
}
NDI void softmax_lazy(f32x16 (&Sv)[2], f32x16& cinit, float& mhat, float& lsum, f32x16 (&O)[2], bool act, bool first) {
    float rm = rowmax2(Sv[0], Sv[1]); if (!act) rm = NEG;
    bool mv = first; float dlt = rm;
    if (!first) { mv = __builtin_amdgcn_ballot_w64(rm > 8.f) != 0ull; dlt = __builtin_fmaxf(rm, 0.f); }
    if (mv) {
        if (!first) { const float f = __builtin_amdgcn_exp2f(-dlt); lsum *= f;
#pragma unroll
            for (int dt = 0; dt < 2; ++dt)
#pragma unroll
                for (int i = 0; i < 16; ++i) O[dt][i] *= f; }
        mhat += dlt; const float nm = -mhat;
#pragma unroll
        for (int i = 0; i < 16; ++i) { Sv[0][i] -= dlt; Sv[1][i] -= dlt; cinit[i] = nm; } }
    float ps = 0.f;
#pragma unroll
    for (int t = 0; t < 2; ++t)
#pragma unroll
        for (int i = 0; i < 16; ++i) { const float p = __builtin_amdgcn_exp2f(Sv[t][i]); Sv[t][i] = p; ps += p; }
    lsum += act ? ps : 0.f;
}
typedef short v4i16_t __attribute__((ext_vector_type(4)));
NDI s16x4 vtr(const LAS char* p) { return __builtin_bit_cast(s16x4, __builtin_amdgcn_ds_read_tr16_b64_v4i16((LAS v4i16_t*)p)); }
NDI void pv_block_m(const f32x16 (&P)[2], f32x16 (&O)[2], const LAS char* vimg, int lane, unsigned am) {
    const LAS char* vp = vimg + ((lane >> 4) & 1) * 32 + (lane & 3) * 8 + (4 * (lane >> 5) + ((lane & 15) >> 2)) * 64;
#pragma unroll
    for (int t = 0; t < 2; ++t)
#pragma unroll
        for (int sp = 0; sp < 2; ++sp) {
            u32x4 w; w.x = pkbf(P[t][8 * sp + 0], P[t][8 * sp + 1]) & am; w.y = pkbf(P[t][8 * sp + 2], P[t][8 * sp + 3]) & am; w.z = pkbf(P[t][8 * sp + 4], P[t][8 * sp + 5]) & am; w.w = pkbf(P[t][8 * sp + 6], P[t][8 * sp + 7]) & am;
            const s16x8 pf = __builtin_bit_cast(s16x8, w);
#pragma unroll
            for (int dt = 0; dt < 2; ++dt) { const LAS char* a = vp + dt * 4096 + (2 * t + sp) * 1024;
                const s16x4 lo = vtr(a), hi = vtr(a + 512);
                const s16x8 af = __builtin_shufflevector(lo, hi, 0, 1, 2, 3, 4, 5, 6, 7);
                O[dt] = NSA_MFMA(af, pf, O[dt]); } }
}
NDI void zero2(f32x16 (&X)[2]) {
#pragma unroll
    for (int dt = 0; dt < 2; ++dt)
#pragma unroll
        for (int i = 0; i < 16; ++i) X[dt][i] = 0.f;
}
NDI void finish_branch(unsigned (&OUTP)[2][8], const f32x16 (&O)[2], float lsum, float gate, bool first) {
    const float lt = hsum32(lsum), sc = lt > 0.f ? gate / lt : 0.f;
#pragma unroll
    for (int dt = 0; dt < 2; ++dt)
#pragma unroll
        for (int i = 0; i < 8; ++i) { const float a = first ? 0.f : bf_lo(OUTP[dt][i]), bq = first ? 0.f : bf_hi(OUTP[dt][i]); OUTP[dt][i] = pkbf(a + O[dt][2 * i] * sc, bq + O[dt][2 * i + 1] * sc); }
}

struct Ptrs { const bf16* QN; const bf16* KV6; const float* GATE; const bf16* KC; const bf16* VC; const float* relb; bf16* MIXB; };

NDI void blk_load(const bf16* kbase, const bf16* vbase, size_t row0, int g, int tid, u32x4& kreg, u32x4& vreg) {
    kreg = *(const u32x4*)(kbase + (row0 + (tid >> 3)) * 256 + g * 64 + (tid & 7) * 8);
    vreg = *(const u32x4*)(vbase + (row0 + (tid >> 3)) * 256 + g * 64 + (tid & 7) * 8);
}
NDI void blk_store(LAS char* L, int buf, int tid, const u32x4& kreg, const u32x4& vreg) {
    *(LAS u32x4*)(L + L_KS + buf * 9216 + (tid >> 3) * KP + (tid & 7) * 16) = kreg;
    *(LAS u32x4*)(L + L_VT + buf * 9216 + ((tid >> 2) & 1) * 4096 + (tid >> 3) * 64 + (tid & 3) * 16) = vreg;
}

NDI void attn_unit(const Ptrs& P, LAS char* L, int tid, int w, int b, int g, int c, bool newtab) {
    asm volatile("" : "+v"(tid)); asm volatile("" : "+s"(w));
    const int lane = tid & 63, r = lane & 31, h = lane >> 5, hh = w >> 1, tl = 32 * (w & 1) + r, tq = 64 * c + tl;
    const size_t tok0 = (size_t)b * S + 64 * c;
    LAS float* biasTab = (LAS float*)(L + L_BIAS); LAS float* stat = (LAS float*)(L + L_STAT);
    LAS float* impA = (LAS float*)(L + L_IMPA); LAS float* impB = (LAS float*)(L + L_IMPB); LAS unsigned* selw = (LAS unsigned*)(L + L_SEL);
    __syncthreads();
    { const int row = tid >> 1, half = tid & 1; const bool ok = row < NCMP;
      const u32x4* ks = (const u32x4*)(P.KC + ((size_t)(b * 4 + g) * NCMP + (ok ? row : 0)) * 64 + 32 * half);
      const u32x4* vs = (const u32x4*)(P.VC + ((size_t)(b * 4 + g) * NCMP + (ok ? row : 0)) * 64 + 32 * half);
#pragma unroll
      for (int q = 0; q < 4; ++q) { u32x4 a = ks[q]; if (!ok) a = (u32x4){0u, 0u, 0u, 0u}; *(LAS u32x4*)(L + L_KC + row * KP + (32 * half + 8 * q) * 2) = a; }
#pragma unroll
      for (int q = 0; q < 4; ++q) { u32x4 a = vs[q]; if (!ok) a = (u32x4){0u, 0u, 0u, 0u};
          *(LAS u32x4*)(L + L_VCT + (row >> 6) * 8192 + half * 4096 + (row & 63) * 64 + q * 16) = a; }
    }
    if (newtab) for (int i = tid; i < 1024; i += NTHR) { const int dist = 191 - (i & 255), hq = g * 4 + (i >> 8); biasTab[i] = LOG2E * (P.relb[rel_bucket(dist) * 16 + hq] - P.relb[31 * 16 + hq]); }
    s16x8 Qf[4];
    { const bf16* qrow = P.QN + (tok0 + tl) * 1024 + (g * 4 + hh) * 64;
#pragma unroll
      for (int s = 0; s < 4; ++s) Qf[s] = *(const s16x8*)(qrow + 16 * s + 8 * h); }
    const float bc31 = 0.f;
    const float* gl = P.GATE + (tok0 + tl) * 64 + g * 4 + hh;
    const float g0 = gl[0], g1 = gl[16], g2 = gl[32];
    __syncthreads();
    const int nv = tq >= 31 ? (tq - 31) / 16 + 1 : 0;
    const int nvmax = (64 * c + 63 - 31) / 16 + 1;
    f32x16 O[2], Sv[2]; zero2(O); unsigned OUTP[2][8];
    float m = NEG, lsum = 0.f;
    const LAS float* btab_h = biasTab + hh * 256;
#pragma unroll 1
    for (int kb = 0; 64 * kb < nvmax; ++kb) {
        st_block(Sv, L + L_KC + 64 * kb * KP, Qf, r, h);
        if (64 * c - (16 * (64 * kb + 63) + 31) < 113) bias_mask<3, 2>(Sv, btab_h, 222 - tq + 16 * (64 * kb + 4 * h), nv - 64 * kb - 4 * h);
        softmax_core(Sv, m, lsum, O, true);
        pv_block_m(Sv, O, L + L_VCT + kb * 8192, lane, 0xffffffffu);
    }
    { const float lt = hsum32(lsum); if (h == 0) { stat[(hh * 64 + tl) * 2] = m; stat[(hh * 64 + tl) * 2 + 1] = lt > 0.f ? 1.f / lt : 0.f; } }
    finish_branch(OUTP, O, lsum, g0, true);
    __syncthreads();
    { const int kq = w >> 1; f32x16 PS[2]; zero2(PS);
      if (64 * kq < nvmax) {
#pragma unroll 1
          for (int hq = 0; hq < 4; ++hq) { s16x8 Q2[4]; const bf16* qrow = P.QN + (tok0 + tl) * 1024 + (g * 4 + hq) * 64;
#pragma unroll
              for (int s = 0; s < 4; ++s) Q2[s] = *(const s16x8*)(qrow + 16 * s + 8 * h);
              f32x16 S2[2]; st_block(S2, L + L_KC + 64 * kq * KP, Q2, r, h);
              const float mm = stat[(hq * 64 + tl) * 2], iv = stat[(hq * 64 + tl) * 2 + 1]; const LAS float* bt = biasTab + hq * 256;
              const int bj0 = 222 - tq + 16 * (64 * kq + 4 * h), lim = nv - 64 * kq - 4 * h;
#pragma unroll
              for (int t = 0; t < 2; ++t)
#pragma unroll
                  for (int i = 0; i < 16; ++i) { const int kc = 32 * t + (i & 3) + 8 * (i >> 2); int j = bj0 + 16 * kc; j = j < 0 ? 0 : (j > 255 ? 255 : j);
                      const float pe = __builtin_amdgcn_exp2f(S2[t][i] + bt[j] - mm) * iv; PS[t][i] += (kc < lim) ? pe : 0.f; } } }
#pragma unroll
      for (int t = 0; t < 2; ++t)
#pragma unroll
          for (int q4 = 0; q4 < 4; ++q4) { const int g4 = 16 * kq + 8 * t + 2 * q4 + h;
              impA[tl * 64 + g4] = (PS[t][4 * q4] + PS[t][4 * q4 + 1]) + (PS[t][4 * q4 + 2] + PS[t][4 * q4 + 3]);
              if (g4 < 63) impB[tl * 64 + g4 + 1] = PS[t][4 * q4 + 3]; }
      if (kq == 0 && h == 0) impB[tl * 64] = 0.f; }
    __syncthreads();
    {
      unsigned key[8], thr[8];
#pragma unroll
      for (int tt = 0; tt < 8; ++tt) { const int tok = 8 * w + tt;
          const float imp = impA[tok * 64 + lane] + impB[tok * 64 + lane];
          const float val = (lane == 0 || lane == c || lane == c - 1) ? 1e9f : (lane > c ? -1e9f : imp);
          const unsigned u = __float_as_uint(val); key[tt] = (u & 0x80000000u) ? ~u : (u | 0x80000000u); thr[tt] = 0u; }
#pragma unroll 1
      for (int bit = 31; bit >= 0; --bit) {
#pragma unroll
          for (int tt = 0; tt < 8; ++tt) { const unsigned cand = thr[tt] | (1u << bit);
              if (__builtin_popcountll(__builtin_amdgcn_ballot_w64(key[tt] >= cand)) >= 16) thr[tt] = cand; } }
#pragma unroll
      for (int tt = 0; tt < 8; ++tt) { const int tok = 8 * w + tt;
          const unsigned long long gt = __builtin_amdgcn_ballot_w64(key[tt] > thr[tt]), eq = __builtin_amdgcn_ballot_w64(key[tt] == thr[tt]);
          const int need = 16 - __builtin_popcountll(gt);
          const bool sel = key[tt] > thr[tt] || (key[tt] == thr[tt] && __builtin_popcountll(eq & ((1ull << lane) - 1ull)) < need);
          const unsigned long long mk = __builtin_amdgcn_ballot_w64(sel && lane <= c);
          if (lane == 0) { selw[2 * tok] = (unsigned)mk; selw[2 * tok + 1] = (unsigned)(mk >> 32); } } }
    __syncthreads();
    unsigned ulo = selw[2 * lane], uhi = selw[2 * lane + 1];
#pragma unroll
    for (int o = 32; o >= 1; o >>= 1) { ulo |= __shfl_xor(ulo, o); uhi |= __shfl_xor(uhi, o); }
    const unsigned long long um = (unsigned long long)__builtin_amdgcn_readfirstlane(ulo) | ((unsigned long long)__builtin_amdgcn_readfirstlane(uhi) << 32);
    __syncthreads();
    const bf16* Ksl = P.KV6 + (size_t)2 * T * 256; const bf16* Vsl = P.KV6 + (size_t)3 * T * 256; const bf16* Kwn = P.KV6 + (size_t)4 * T * 256; const bf16* Vwn = P.KV6 + (size_t)5 * T * 256;
    u32x4 kreg, vreg; f32x16 cinit;
    { unsigned long long rem = um & ~(1ull << c);
      int cur = c, n = 0; zero2(O); m = 0.f; lsum = 0.f;
#pragma unroll
      for (int i = 0; i < 16; ++i) cinit[i] = 0.f;
      blk_load(Ksl, Vsl, (size_t)b * S + 64 * cur, g, tid, kreg, vreg); blk_store(L, 0, tid, kreg, vreg);
      __syncthreads();
      while (cur >= 0) {
          const int nxt = rem ? 63 - __builtin_clzll(rem) : -1; if (nxt >= 0) rem &= ~(1ull << nxt);
          if (nxt >= 0) blk_load(Ksl, Vsl, (size_t)b * S + 64 * nxt, g, tid, kreg, vreg);
          const int buf = n & 1, dl = c - cur; const bool act = (selw[2 * tl + (cur >> 5)] >> (cur & 31)) & 1u;
          st_block_c(Sv, L + L_KS + buf * 9216, Qf, r, h, cinit);
          if (dl == 0) bias_mask<1, 1>(Sv, btab_h + (191 - tl + 4 * h), 0, tl - 4 * h);
          else if (dl <= 2) bias_mask<0, 1>(Sv, btab_h + (191 - 64 * dl - tl + 4 * h), 0, 0);
          softmax_lazy(Sv, cinit, m, lsum, O, act, n == 0);
          pv_block_m(Sv, O, L + L_VT + buf * 9216, lane, act ? 0xffffffffu : 0u);
          if (nxt >= 0) blk_store(L, buf ^ 1, tid, kreg, vreg);
          __syncthreads();
          cur = nxt; ++n; }
      finish_branch(OUTP, O, lsum, g1, false); }
    { int cur = c, n = 0; const int last = c >= 8 ? c - 8 : 0; zero2(O); m = 0.f; lsum = 0.f;
#pragma unroll
      for (int i = 0; i < 16; ++i) cinit[i] = 0.f;
      blk_load(Kwn, Vwn, (size_t)b * S + 64 * cur, g, tid, kreg, vreg); blk_store(L, 0, tid, kreg, vreg);
      __syncthreads();
      while (cur >= last) {
          const int nxt = cur - 1; const bool more = nxt >= last;
          if (more) blk_load(Kwn, Vwn, (size_t)b * S + 64 * nxt, g, tid, kreg, vreg);
          const int buf = n & 1, dl = c - cur;
          st_block_c(Sv, L + L_KS + buf * 9216, Qf, r, h, cinit);
          if (dl == 0) bias_mask<1, 1>(Sv, btab_h + (191 - tl + 4 * h), 0, tl - 4 * h);
          else if (dl <= 2) bias_mask<0, 1>(Sv, btab_h + (191 - 64 * dl - tl + 4 * h), 0, 0);
          else if (dl == 8) bias_mask<2, 0>(Sv, btab_h, 0, tl - 4 * h);
          softmax_lazy(Sv, cinit, m, lsum, O, true, n == 0);
          pv_block_m(Sv, O, L + L_VT + buf * 9216, lane, 0xffffffffu);
          if (more) blk_store(L, buf ^ 1, tid, kreg, vreg);
          __syncthreads();
          cur = nxt; ++n; }
      finish_branch(OUTP, O, lsum, g2, false); }
    { int tl2 = tl; asm volatile("" : "+v"(tl2));
      bf16* orow = P.MIXB + (tok0 + tl2) * 2048 + 1024 + (g * 4 + hh) * 64;
#pragma unroll
      for (int dt = 0; dt < 2; ++dt)
#pragma unroll
          for (int q4 = 0; q4 < 4; ++q4) { u32x2 o; o.x = OUTP[dt][2 * q4]; o.y = OUTP[dt][2 * q4 + 1];
              *(u32x2*)(orow + 32 * dt + 8 * q4 + 4 * h) = o; } }
}
#undef NSA_MFMA
#undef NSA_MX3
#undef NDI
}

namespace hg {
typedef float f32x16 __attribute__((ext_vector_type(16)));
typedef short s16x8 __attribute__((ext_vector_type(8)));
typedef short s16x4 __attribute__((ext_vector_type(4)));
typedef float f32x2e __attribute__((ext_vector_type(2)));
#define HG_MFMA(a, b, c) __builtin_amdgcn_mfma_f32_32x32x16_bf16((a), (b), (c), 0, 0, 0)
#define HDI __device__ __forceinline__
constexpr int QP = 272, HP = 144, SP = 272;
constexpr int L_QT = 0, L_KT = 17408, L_KHT = 34816, L_VT = 53248, L_ST = 71680, L_BL = 106496, L_PART = 107008;
struct Ptrs { const bf16* QH; const bf16* LOGF; const bf16* VH; const bf16* GH; const float* ng; bf16* MIXB; float* SLOC; float* LSUM; };

template <bool PASS2>
HDI void item(const Ptrs& P, LAS char* L, int tid, int w, int it) {
    asm volatile("" : "+v"(tid)); asm volatile("" : "+s"(w));
    const int lane = tid & 63, r = lane & 31, h = lane >> 5;
    const int b = it >> 6, hd = (it >> 3) & 7, seg = it & 7;
    if (!PASS2 && seg == 7) return;
    LAS float* bl = (LAS float*)(L + L_BL); LAS float* part = (LAS float*)(L + L_PART);
    const int dkt = w >> 1, dvp = w & 1;
    f32x16 ST[2];
#pragma unroll
    for (int j = 0; j < 2; ++j)
#pragma unroll
        for (int i = 0; i < 16; ++i) ST[j][i] = 0.f;
    __syncthreads();
    if (PASS2) {
        float lsv[16], slv[2][16];
        if (seg > 0) { const int pit = (it & ~7); const float* ls = P.LSUM + (size_t)pit * 128; const float* sl = P.SLOC + (size_t)pit * 16384;
#pragma unroll
            for (int i = 0; i < 16; ++i) { const int dk = 32 * dkt + 8 * (i >> 2) + 4 * h + (i & 3); lsv[i] = ls[dk];
#pragma unroll
                for (int j = 0; j < 2; ++j) slv[j][i] = sl[dk * 128 + 32 * (2 * dvp + j) + r]; } }
        for (int sj = 0; sj < seg; ++sj) {
            float lsc[16], slc[2][16];
#pragma unroll
            for (int i = 0; i < 16; ++i) { lsc[i] = lsv[i]; slc[0][i] = slv[0][i]; slc[1][i] = slv[1][i]; }
            if (sj + 1 < seg) { const int pit = (it & ~7) + sj + 1; const float* ls = P.LSUM + (size_t)pit * 128; const float* sl = P.SLOC + (size_t)pit * 16384;
#pragma unroll
                for (int i = 0; i < 16; ++i) { const int dk = 32 * dkt + 8 * (i >> 2) + 4 * h + (i & 3); lsv[i] = ls[dk];
#pragma unroll
                    for (int j = 0; j < 2; ++j) slv[j][i] = sl[dk * 128 + 32 * (2 * dvp + j) + r]; } }
#pragma unroll
            for (int j = 0; j < 2; ++j)
#pragma unroll
                for (int i = 0; i < 16; ++i) ST[j][i] = __expf(lsc[i]) * ST[j][i] + slc[j][i]; }
#pragma unroll
        for (int j = 0; j < 2; ++j)
#pragma unroll
            for (int q4 = 0; q4 < 4; ++q4) { u32x2 o; o.x = nsa::pkbf(ST[j][4 * q4], ST[j][4 * q4 + 1]); o.y = nsa::pkbf(ST[j][4 * q4 + 2], ST[j][4 * q4 + 3]);
                *(LAS u32x2*)(L + L_ST + (32 * (2 * dvp + j) + r) * SP + (32 * dkt + 8 * q4 + 4 * h) * 2) = o; }
    }
    float lsum_d[2] = {0.f, 0.f};
    const size_t rowbase = (size_t)b * S + seg * 512;
    const int d2 = tid & 63, tq8 = tid >> 6;
    unsigned lf2[8], qv2[8], vv2[8];
    { const size_t o0 = (rowbase + 8 * tq8) * 1024 + hd * 128 + 2 * d2;
#pragma unroll
      for (int i = 0; i < 8; ++i) { lf2[i] = *(const unsigned*)(P.LOGF + o0 + (size_t)i * 1024); vv2[i] = *(const unsigned*)(P.VH + o0 + (size_t)i * 1024); if (PASS2) qv2[i] = *(const unsigned*)(P.QH + o0 + (size_t)i * 1024); } }
    for (int ck = 0; ck < 8; ++ck) {
        const size_t row0 = rowbase + ck * 64;
        float cs[2][8]; float run[2] = {0.f, 0.f};
#pragma unroll
        for (int i = 0; i < 8; ++i) { run[0] += bf_lo(lf2[i]); cs[0][i] = run[0]; run[1] += bf_hi(lf2[i]); cs[1][i] = run[1]; }
        *(LAS f32x2e*)(part + tq8 * 128 + 2 * d2) = (f32x2e){run[0], run[1]};
        __syncthreads();
        float off[2] = {0.f, 0.f}, tot[2] = {0.f, 0.f};
#pragma unroll
        for (int j = 0; j < 8; ++j) { const f32x2e pj = *(const LAS f32x2e*)(part + j * 128 + 2 * d2); tot[0] += pj[0]; tot[1] += pj[1]; off[0] += (j < tq8) ? pj[0] : 0.f; off[1] += (j < tq8) ? pj[1] : 0.f; }
        if (tq8 == 0) { bl[2 * d2] = __expf(tot[0]); bl[2 * d2 + 1] = __expf(tot[1]); lsum_d[0] += tot[0]; lsum_d[1] += tot[1]; }
        float khv[2][8];
#pragma unroll
        for (int i = 0; i < 8; ++i) { float qt[2], kt[2];
#pragma unroll
            for (int e = 0; e < 2; ++e) { const float lfe = e ? bf_hi(lf2[i]) : bf_lo(lf2[i]), bb = off[e] + cs[e][i], f = __expf(lfe), k = 1.f - f;
                khv[e][i] = k * __expf(tot[e] - bb);
                if (PASS2) { qt[e] = (e ? bf_hi(qv2[i]) : bf_lo(qv2[i])) * __expf(bb); kt[e] = k * __expf(-bb); } }
            if (PASS2) { const int t = 8 * tq8 + i;
                *(LAS unsigned*)(L + L_QT + t * QP + 4 * d2) = nsa::pkbf(qt[0], qt[1]);
                *(LAS unsigned*)(L + L_KT + t * QP + 4 * d2) = nsa::pkbf(kt[0], kt[1]); } }
#pragma unroll
        for (int e = 0; e < 2; ++e) { const int d = 2 * d2 + e;
            u32x4 a; a.x = nsa::pkbf(khv[e][0], khv[e][1]); a.y = nsa::pkbf(khv[e][2], khv[e][3]); a.z = nsa::pkbf(khv[e][4], khv[e][5]); a.w = nsa::pkbf(khv[e][6], khv[e][7]);
            *(LAS u32x4*)(L + L_KHT + d * HP + 16 * tq8) = a;
            u32x4 v;
            if (e == 0) { v.x = (vv2[0] & 0xffffu) | (vv2[1] << 16); v.y = (vv2[2] & 0xffffu) | (vv2[3] << 16); v.z = (vv2[4] & 0xffffu) | (vv2[5] << 16); v.w = (vv2[6] & 0xffffu) | (vv2[7] << 16); }
            else        { v.x = (vv2[0] >> 16) | (vv2[1] & 0xffff0000u); v.y = (vv2[2] >> 16) | (vv2[3] & 0xffff0000u); v.z = (vv2[4] >> 16) | (vv2[5] & 0xffff0000u); v.w = (vv2[6] >> 16) | (vv2[7] & 0xffff0000u); }
            *(LAS u32x4*)(L + L_VT + d * HP + 16 * tq8) = v; }
        if (ck < 7) { const size_t o0 = (row0 + 64 + 8 * tq8) * 1024 + hd * 128 + 2 * d2;
#pragma unroll
            for (int i = 0; i < 8; ++i) { lf2[i] = *(const unsigned*)(P.LOGF + o0 + (size_t)i * 1024); vv2[i] = *(const unsigned*)(P.VH + o0 + (size_t)i * 1024); if (PASS2) qv2[i] = *(const unsigned*)(P.QH + o0 + (size_t)i * 1024); } }
        __syncthreads();
        if (PASS2) { const int dvt = w >> 1, tt = w & 1;
            u32x2 gbv[4];
            { const size_t base = (row0 + 32 * tt + r) * 1024 + hd * 128 + 32 * dvt + 4 * h;
#pragma unroll
              for (int q4 = 0; q4 < 4; ++q4) gbv[q4] = *(const u32x2*)(P.GH + base + 8 * q4); }
            f32x4 nvv[4];
#pragma unroll
            for (int q4 = 0; q4 < 4; ++q4) nvv[q4] = *(const f32x4*)(P.ng + 32 * dvt + 4 * h + 8 * q4);
            s16x8 fq[8], fs[8], fk[8];
#pragma unroll
            for (int ks = 0; ks < 8; ++ks) { fq[ks] = *(const LAS s16x8*)(L + L_QT + (32 * tt + r) * QP + 32 * ks + 16 * h); fk[ks] = *(const LAS s16x8*)(L + L_KT + r * QP + 32 * ks + 16 * h); }
#pragma unroll
            for (int ks = 0; ks < 8; ++ks) fs[ks] = *(const LAS s16x8*)(L + L_ST + (32 * dvt + r) * SP + 32 * ks + 16 * h);
            __builtin_amdgcn_sched_barrier(0);
            f32x16 O;
#pragma unroll
            for (int i = 0; i < 16; ++i) O[i] = 0.f;
#pragma unroll
            for (int st = 0; st < 2; ++st) if (st <= tt) { f32x16 acc;
#pragma unroll
                for (int i = 0; i < 16; ++i) acc[i] = 0.f;
                s16x4 vlo[2], vhi[2];
#pragma unroll
                for (int sp = 0; sp < 2; ++sp) { const LAS char* ap = L + L_VT + (32 * dvt + r) * HP + (32 * st + 16 * sp + 4 * h) * 2; vlo[sp] = *(const LAS s16x4*)ap; vhi[sp] = *(const LAS s16x4*)(ap + 16); }
#pragma unroll
                for (int ks = 0; ks < 8; ++ks) acc = HG_MFMA(fk[ks], fq[ks], acc);
                if (st == 0 && tt == 1) {
#pragma unroll
                    for (int ks = 0; ks < 8; ++ks) fk[ks] = *(const LAS s16x8*)(L + L_KT + (32 + r) * QP + 32 * ks + 16 * h); }
                if (st == tt) {
#pragma unroll
                    for (int i = 0; i < 16; ++i) acc[i] = ((i & 3) + 8 * (i >> 2) + 4 * h <= r) ? acc[i] : 0.f; }
#pragma unroll
                for (int sp = 0; sp < 2; ++sp) { u32x4 pw; pw.x = nsa::pkbf(acc[8 * sp + 0], acc[8 * sp + 1]); pw.y = nsa::pkbf(acc[8 * sp + 2], acc[8 * sp + 3]); pw.z = nsa::pkbf(acc[8 * sp + 4], acc[8 * sp + 5]); pw.w = nsa::pkbf(acc[8 * sp + 6], acc[8 * sp + 7]);
                    const s16x8 pf = __builtin_bit_cast(s16x8, pw);
                    O = HG_MFMA(__builtin_shufflevector(vlo[sp], vhi[sp], 0, 1, 2, 3, 4, 5, 6, 7), pf, O); } }
#pragma unroll
            for (int ks = 0; ks < 8; ++ks) O = HG_MFMA(fs[ks], fq[ks], O);
            LAS float* ssq = (LAS float*)(L + L_PART + 4096);
            { float q2 = 0.f;
#pragma unroll
              for (int i = 0; i < 16; ++i) q2 += O[i] * O[i];
              q2 = nsa::hsum32(q2); if (h == 0) ssq[dvt * 64 + 32 * tt + r] = q2; }
            __syncthreads();
            { const int tloc = 32 * tt + r; const float tot = (ssq[tloc] + ssq[64 + tloc]) + (ssq[128 + tloc] + ssq[192 + tloc]);
              const float rs = rsqrtf(tot * (1.f / 128.f) + EPS);
              const size_t base = (row0 + tloc) * 1024 + hd * 128 + 32 * dvt + 4 * h;
#pragma unroll
              for (int q4 = 0; q4 < 4; ++q4) { const u32x2 gb = gbv[q4]; const f32x4 nv = nvv[q4];
                  u32x2 ov; ov.x = nsa::pkbf(O[4 * q4] * rs * nv[0] * bf_lo(gb.x), O[4 * q4 + 1] * rs * nv[1] * bf_hi(gb.x)); ov.y = nsa::pkbf(O[4 * q4 + 2] * rs * nv[2] * bf_lo(gb.y), O[4 * q4 + 3] * rs * nv[3] * bf_hi(gb.y));
                  *(u32x2*)(P.MIXB + (row0 + tloc) * 2048 + hd * 128 + 32 * dvt + 4 * h + 8 * q4) = ov; } }
        }
        { s16x8 ka[4], vb[2][4];
#pragma unroll
          for (int ks = 0; ks < 4; ++ks) { ka[ks] = *(const LAS s16x8*)(L + L_KHT + (32 * dkt + r) * HP + 32 * ks + 16 * h);
#pragma unroll
              for (int j = 0; j < 2; ++j) vb[j][ks] = *(const LAS s16x8*)(L + L_VT + (32 * (2 * dvp + j) + r) * HP + 32 * ks + 16 * h); }
          __builtin_amdgcn_sched_barrier(0);
#pragma unroll
          for (int j = 0; j < 2; ++j) { f32x16 acc = ST[j];
#pragma unroll
              for (int i = 0; i < 16; ++i) acc[i] *= bl[32 * dkt + 8 * (i >> 2) + 4 * h + (i & 3)];
#pragma unroll
              for (int ks = 0; ks < 4; ++ks) acc = HG_MFMA(ka[ks], vb[j][ks], acc);
              ST[j] = acc; } }
        if (PASS2) {
            __syncthreads();
#pragma unroll
            for (int j = 0; j < 2; ++j)
#pragma unroll
                for (int q4 = 0; q4 < 4; ++q4) { u32x2 o; o.x = nsa::pkbf(ST[j][4 * q4], ST[j][4 * q4 + 1]); o.y = nsa::pkbf(ST[j][4 * q4 + 2], ST[j][4 * q4 + 3]);
                    *(LAS u32x2*)(L + L_ST + (32 * (2 * dvp + j) + r) * SP + (32 * dkt + 8 * q4 + 4 * h) * 2) = o; }
        }
    }
    if (!PASS2) {
        float* sl = P.SLOC + (size_t)it * 16384;
#pragma unroll
        for (int j = 0; j < 2; ++j)
#pragma unroll
            for (int i = 0; i < 16; ++i) sl[(32 * dkt + 8 * (i >> 2) + 4 * h + (i & 3)) * 128 + 32 * (2 * dvp + j) + r] = ST[j][i];
        if (tq8 == 0) { P.LSUM[(size_t)it * 128 + 2 * d2] = lsum_d[0]; P.LSUM[(size_t)it * 128 + 2 * d2 + 1] = lsum_d[1]; }
    }
}
#undef HG_MFMA
#undef HDI
}


namespace wg {
typedef float f32x16 __attribute__((ext_vector_type(16)));
typedef short s16x8 __attribute__((ext_vector_type(8)));
typedef short s16x4 __attribute__((ext_vector_type(4)));
#define WG_MFMA(a, b, c) __builtin_amdgcn_mfma_f32_32x32x16_bf16((a), (b), (c), 0, 0, 0)
__device__ __forceinline__ void router_partial(const bf16* XNB, const bf16* WRT, LAS float* red, int item, int kq, int w, int lane) {
    const int r = lane & 31, h = lane >> 5; const size_t tok0 = (size_t)item * 32;
    f32x16 acc[3];
#pragma unroll
    for (int nt = 0; nt < 3; ++nt)
#pragma unroll
        for (int i = 0; i < 16; ++i) acc[nt][i] = 0.f;
    const bf16* ap = XNB + (tok0 + r) * 2048 + 512 * kq + 8 * h; const bf16* bp = WRT + ((size_t)(32 * kq) * 64 + lane) * 8;
#pragma unroll 8
    for (int s = 0; s < 32; ++s) { const s16x8 a = *(const s16x8*)(ap + 16 * s);
#pragma unroll
        for (int nt = 0; nt < 3; ++nt) { const s16x8 b = *(const s16x8*)(bp + (size_t)(nt * 128 + s) * 512); acc[nt] = WG_MFMA(a, b, acc[nt]); } }
#pragma unroll
    for (int nt = 0; nt < 3; ++nt)
#pragma unroll
        for (int i = 0; i < 16; ++i) red[(w * 48 + nt * 16 + i) * 64 + lane] = acc[nt][i];
}
__device__ __forceinline__ void router_reduce(const LAS float* red, const float* BR, float* RLOG, int item, int kq, int w, int lane) {
    if (kq < 3) { const int r = lane & 31, h = lane >> 5, nt = kq, w0 = w & ~3; const size_t tok0 = (size_t)item * 32; const float bias = BR[32 * nt + r];
#pragma unroll
        for (int i = 0; i < 16; ++i) { const int o = (nt * 16 + i) * 64 + lane;
            const float v = (red[(w0 * 48) * 64 + o] + red[((w0 + 1) * 48) * 64 + o]) + (red[((w0 + 2) * 48) * 64 + o] + red[((w0 + 3) * 48) * 64 + o]);
            RLOG[(tok0 + 8 * (i >> 2) + 4 * h + (i & 3)) * 128 + 32 * nt + r] = v + bias; } }
}
__device__ __forceinline__ void compress_block(const bf16* src  , const float* pe  , const bf16* W1F  , const bf16* W2T  , bf16* outp  ,
                                               LAS float* red, int item, int w, int lane) {
    const int r = lane & 31, h = lane >> 5;
    const int row = item * 32 + r;
    constexpr int AP = 4112;
    LAS char* Ab = (LAS char*)red; LAS float* pes = (LAS float*)(Ab + 32 * AP);
    { const int tid = w * 64 + lane;
      for (int i = tid; i < 512; i += 512) *(LAS f32x4*)(pes + 4 * i) = *(const f32x4*)(pe + 4 * i);
      __syncthreads();
#pragma unroll 8
      for (int j = 0; j < 16; ++j) { const int p = tid + 512 * j, rr = p >> 8, l = (p >> 3) & 31, q = p & 7;
          const int rw = item * 32 + rr, rc = rw < 4080 ? rw : 4079, bg = rc / NCMP, ic = rc % NCMP;
          const u32x4 raw = *(const u32x4*)(src + ((size_t)(bg >> 2) * S + 16 * ic + l) * 256 + (bg & 3) * 64 + 8 * q);
          const f32x4 p0 = *(const LAS f32x4*)(pes + l * 64 + 8 * q), p1 = *(const LAS f32x4*)(pes + l * 64 + 8 * q + 4);
          u32x4 av; av.x = nsa::pkbf(bf_lo(raw.x) + p0[0], bf_hi(raw.x) + p0[1]); av.y = nsa::pkbf(bf_lo(raw.y) + p0[2], bf_hi(raw.y) + p0[3]);
          av.z = nsa::pkbf(bf_lo(raw.z) + p1[0], bf_hi(raw.z) + p1[1]); av.w = nsa::pkbf(bf_lo(raw.w) + p1[2], bf_hi(raw.w) + p1[3]);
          *(LAS u32x4*)(Ab + rr * AP + (l * 64 + 8 * q) * 2) = av; }
      __syncthreads(); }
    f32x16 acc;
#pragma unroll
    for (int i = 0; i < 16; ++i) acc[i] = 0.f;
    const bf16* wp = W1F + ((size_t)w * 128 * 64 + lane) * 8;
    const LAS char* ap = Ab + r * AP + 16 * h;
    s16x8 wq[2][16];
#define CB_LOAD(q, s0) do { _Pragma("unroll") for (int j_ = 0; j_ < 16; ++j_) wq[q][j_] = *(const s16x8*)(wp + (size_t)((s0) + j_) * 512); } while (0)
#define CB_MMA(q, s0) do { _Pragma("unroll") for (int j_ = 0; j_ < 16; ++j_) { const s16x8 av = *(const LAS s16x8*)(ap + 32 * ((s0) + j_)); acc = WG_MFMA(wq[q][j_], av, acc); } } while (0)
    CB_LOAD(0, 0);
#pragma unroll 1
    for (int s = 0; s < 128; s += 32) {
        CB_LOAD(1, s + 16); __builtin_amdgcn_sched_barrier(0); CB_MMA(0, s); __builtin_amdgcn_sched_barrier(0);
        if (s + 32 < 128) CB_LOAD(0, s + 32);
        __builtin_amdgcn_sched_barrier(0); CB_MMA(1, s + 16); __builtin_amdgcn_sched_barrier(0); }
#undef CB_LOAD
#undef CB_MMA
    __syncthreads();
    f32x16 o[2];
#pragma unroll
    for (int dt = 0; dt < 2; ++dt)
#pragma unroll
        for (int i = 0; i < 16; ++i) o[dt][i] = 0.f;
#pragma unroll
    for (int sp = 0; sp < 2; ++sp) { u32x4 pw; float hv[8];
#pragma unroll
        for (int j = 0; j < 8; ++j) { const float x = acc[8 * sp + j]; hv[j] = x * __builtin_amdgcn_rcpf(1.f + __expf(-x)); }
        pw.x = nsa::pkbf(hv[0], hv[1]); pw.y = nsa::pkbf(hv[2], hv[3]); pw.z = nsa::pkbf(hv[4], hv[5]); pw.w = nsa::pkbf(hv[6], hv[7]);
        const s16x8 pf = __builtin_bit_cast(s16x8, pw);
#pragma unroll
        for (int dt = 0; dt < 2; ++dt) { const bf16* w2 = W2T + (size_t)(32 * dt + r) * 256 + 32 * w + 16 * sp + 4 * h;
            const s16x4 lo = *(const s16x4*)w2, hi = *(const s16x4*)(w2 + 8);
            o[dt] = WG_MFMA(__builtin_shufflevector(lo, hi, 0, 1, 2, 3, 4, 5, 6, 7), pf, o[dt]); } }
#pragma unroll
    for (int dt = 0; dt < 2; ++dt)
#pragma unroll
        for (int i = 0; i < 16; ++i) red[(w * 32 + dt * 16 + i) * 64 + lane] = o[dt][i];
    __syncthreads();
    { const int dt = w >> 2, q4 = w & 3; float v[4];
#pragma unroll
      for (int j = 0; j < 4; ++j) { float a = 0.f;
#pragma unroll
          for (int ws = 0; ws < 8; ++ws) a += red[(ws * 32 + dt * 16 + 4 * q4 + j) * 64 + lane];
          v[j] = a; }
      if (row < 4080) { u32x2 ov; ov.x = nsa::pkbf(v[0], v[1]); ov.y = nsa::pkbf(v[2], v[3]); *(u32x2*)(outp + (size_t)row * 64 + 32 * dt + 8 * q4 + 4 * h) = ov; } }
    __syncthreads();
}
#undef WG_MFMA
}

__device__ __forceinline__ void ph_hgrn_rec(const Frame& F) {
    { const hg::Ptrs P{F.w<bf16>(WS_QH), F.w<bf16>(WS_LOGF), F.w<bf16>(WS_VH), F.w<bf16>(WS_GH), F.i_hg_norm_g, F.w<bf16>(WS_MIXB), F.w<float>(WS_SLOC), F.w<float>(WS_LSUM)};
      for (int it = blockIdx.x; it < 256; it += gridDim.x) hg::item<false>(P, (LAS char*)F.lds, F.tid, F.wave, it); }
    __syncthreads();
    for (int it = blockIdx.x; it < 256; it += gridDim.x) { const int which = it >> 7;
        wg::compress_block(F.w<bf16>(WS_KV6) + (size_t)which * T * 256, which ? F.i_pe_v : F.i_pe_k, F.w<bf16>(WS_W1T) + (size_t)which * 256 * 2048, F.w<bf16>(WS_W2T) + (size_t)which * 64 * 256,
                           F.w<bf16>(which ? WS_VCB : WS_KCB), (LAS float*)F.lds, it & 127, F.wave, F.lane); }
}

__device__ __forceinline__ void ph_hgrn_norm_cmp1(const Frame& F) {
    { const hg::Ptrs P{F.w<bf16>(WS_QH), F.w<bf16>(WS_LOGF), F.w<bf16>(WS_VH), F.w<bf16>(WS_GH), F.i_hg_norm_g, F.w<bf16>(WS_MIXB), F.w<float>(WS_SLOC), F.w<float>(WS_LSUM)};
      for (int it = blockIdx.x; it < 256; it += gridDim.x) hg::item<true>(P, (LAS char*)F.lds, F.tid, F.wave, it); }
}
__device__ __forceinline__ void ph_attn(const Frame& F) {
    const nsa::Ptrs P{F.w<bf16>(WS_QN), F.w<bf16>(WS_KV6), F.w<float>(WS_GATE), F.w<bf16>(WS_KCB), F.w<bf16>(WS_VCB), F.i_rel_bias, F.w<bf16>(WS_MIXB)};
    for (int su = blockIdx.x; su < 256; su += gridDim.x) { const int bg = su >> 4, j = su & 15;
        for (int q = 0; q < 4; ++q) { const int c = q == 0 ? 63 - j : (q == 1 ? 32 + j : (q == 2 ? 31 - j : j)); nsa::attn_unit(P, (LAS char*)F.lds, F.tid, F.wave, bg >> 2, bg & 3, c, q == 0); } }
}
__device__ __forceinline__ void ph_outproj(const Frame& F) {
    pg8::Gemm g{F.w<bf16>(WS_MIXB), F.w<bf16>(WS_WOUTT), T, D, D}; pg8::StaticOrder So; So.init(T, D, (int)gridDim.x, (int)blockIdx.x);
    pg8::EpiRes E{F.w<pg8::bf16_t>(WS_X2), F.i_x, D};
    pg8::gemm_phase<pg8::EpiRes, pg8::StaticOrder, false, true>(F.lds, g, So, E, F.wave);
}
__device__ __forceinline__ void route_token(const float* RLOG, int* cnt, int* LISTI, float* LISTW, int t) {
        const float* lg = RLOG + (size_t)t * 128;
        float m = lg[0]; int gt = 0;
#pragma unroll
        for (int j = 1; j < 8; ++j) if (lg[j] > m) { m = lg[j]; gt = j; }
        float sum = 0.f;
#pragma unroll
        for (int j = 0; j < 8; ++j) sum += expf(lg[j] - m);
        const float ptop = 1.f / sum;
        const float* le = lg + 8 + gt * 8;
        float v0 = le[0]; int i0 = 0;
#pragma unroll
        for (int j = 1; j < 8; ++j) if (le[j] > v0) { v0 = le[j]; i0 = j; }
        float v1 = -3e38f; int i1 = -1;
#pragma unroll
        for (int j = 0; j < 8; ++j) if (j != i0 && (i1 < 0 || le[j] > v1)) { v1 = le[j]; i1 = j; }
        const float e1 = expf(v1 - v0), w0 = 1.f / (1.f + e1), w1 = e1 / (1.f + e1);
        const int ex0 = gt * 8 + i0, ex1 = gt * 8 + i1;
        const int p0 = atomicAdd(&cnt[ex0 * CNT_STRIDE], 1), p1 = atomicAdd(&cnt[ex1 * CNT_STRIDE], 1);
        LISTI[ex0 * 16384 + p0] = 2 * t; LISTW[ex0 * 16384 + p0] = ptop * w0; LISTI[ex1 * 16384 + p1] = 2 * t + 1; LISTW[ex1 * 16384 + p1] = ptop * w1;
}
__device__ __forceinline__ void ph_router_logits(const Frame& F) {
    LAS float* red = (LAS float*)F.lds;
    const bf16* X2 = F.w<bf16>(WS_X2); const float* g2 = F.i_norm2_g; bf16* XNB = F.w<bf16>(WS_XNB);
    for (int it0 = blockIdx.x * 2; it0 < T / 32; it0 += gridDim.x * 2) { const int item = it0 + (F.wave >> 2), kq = F.wave & 3;
        { u32x2 xa[8][8];
          float4 gw[8];
#pragma unroll
          for (int j = 0; j < 8; ++j) gw[j] = ((const float4*)g2)[F.lane + 64 * j];
          const int m0 = it0 * 32 + F.wave * 8;
#pragma unroll
          for (int j8 = 0; j8 < 8; ++j8) { const u32x2* xr = (const u32x2*)(X2 + (size_t)(m0 + j8) * D);
#pragma unroll
              for (int j = 0; j < 8; ++j) xa[j8][j] = xr[F.lane + 64 * j]; }
#pragma unroll
          for (int j8 = 0; j8 < 8; ++j8) { float ss = 0.f;
#pragma unroll
              for (int j = 0; j < 8; ++j) { const u32x2 a = xa[j8][j]; const float x0 = bf_lo(a.x), x1 = bf_hi(a.x), x2 = bf_lo(a.y), x3 = bf_hi(a.y); ss += x0 * x0 + x1 * x1 + x2 * x2 + x3 * x3; }
              const float rr = rsqrtf(wave_sum(ss) * (1.f / D) + EPS);
              u32x2* hb = (u32x2*)(XNB + (size_t)(m0 + j8) * D);
#pragma unroll
              for (int j = 0; j < 8; ++j) { const u32x2 a = xa[j8][j]; const float4 g = gw[j]; u32x2 ob; ob.x = pk2(bf_lo(a.x) * rr * g.x, bf_hi(a.x) * rr * g.y); ob.y = pk2(bf_lo(a.y) * rr * g.z, bf_hi(a.y) * rr * g.w); hb[F.lane + 64 * j] = ob; } } }
        asm volatile("s_waitcnt vmcnt(0)" ::: "memory");
        __syncthreads();
        wg::router_partial(F.w<bf16>(WS_XNB), F.w<bf16>(WS_WRT), red, item, kq, F.wave, F.lane);
        __syncthreads();
        wg::router_reduce(red, F.w<float>(WS_BR), F.w<float>(WS_RLOG), item, kq, F.wave, F.lane);
        asm volatile("s_waitcnt vmcnt(0)" ::: "memory");
        __syncthreads();
        if (kq == 0 && F.lane < 32) route_token(F.w<float>(WS_RLOG), F.w<int>(WS_CTL) + CW_CNT, F.w<int>(WS_LISTI), F.w<float>(WS_LISTW), item * 32 + F.lane); }
}
constexpr int LDS_TAB = 131072;
__device__ __forceinline__ void expert_offsets(const Frame& F, LAS int* offs, LAS int* cnts, LAS int* rt_exp) {
    const int* cnt = F.w<int>(WS_CTL) + CW_CNT;
    __syncthreads();
    if (F.wave == 0) {
        const int e = F.lane, cn = cnt[e * CNT_STRIDE], n = (cn + 255) >> 8;
        int inc = n;
#pragma unroll
        for (int o = 1; o < 64; o <<= 1) { const int v = __shfl_up(inc, o); if (e >= o) inc += v; }
        const int excl = inc - n;
        cnts[e] = cn; offs[e] = excl * 256; if (e == 63) offs[64] = inc * 256;
        for (int j = 0; j < n; ++j) rt_exp[excl + j] = e;
    }
    __syncthreads();
}
__device__ __forceinline__ void ph_moe1(const Frame& F) {
    LAS int* offs = (LAS int*)(F.lds + LDS_TAB); LAS int* cnts = offs + 128; LAS int* rt_exp = offs + 256;
    expert_offsets(F, offs, cnts, rt_exp);
    pg8::GroupedOrder So; So.init(rt_exp, (offs[64] >> 8) * 8, (int)gridDim.x, (int)blockIdx.x);
    pg8::EpiSwiGLU E{F.w<bf16>(WS_HID)};
    pg8::moe_gemm<pg8::EpiSwiGLU, true>(F.lds, F.w<bf16>(WS_XNB), F.w<int>(WS_LISTI), F.i_weg, F.i_weu, offs, cnts, So, E, F.wave);
}
__device__ __forceinline__ void ph_moe2(const Frame& F) {
    LAS int* offs = (LAS int*)(F.lds + LDS_TAB); LAS int* cnts = offs + 128; LAS int* rt_exp = offs + 256;
    expert_offsets(F, offs, cnts, rt_exp);
    pg8::GroupedOrder So; So.init(rt_exp, (offs[64] >> 8) * 8, (int)gridDim.x, (int)blockIdx.x);
    pg8::EpiMoeOut E{F.w<bf16>(WS_Y2), F.w<int>(WS_LISTI), F.w<float>(WS_LISTW), offs, cnts};
    pg8::moe_gemm<pg8::EpiMoeOut, false>(F.lds, F.w<bf16>(WS_HID), F.w<int>(WS_LISTI), F.i_wed, F.i_wed, offs, cnts, So, E, F.wave);
}
__device__ __forceinline__ void ph_final(const Frame& F) {
    const bf16* X2 = F.w<bf16>(WS_X2); const bf16* Y2 = F.w<bf16>(WS_Y2); const float* gf = F.i_final_g;
    u32x2 xa[8], ya[8], yb[8], xn[8], yan[8], ybn[8];
    float4 gw[8];
#pragma unroll
    for (int j = 0; j < 8; ++j) gw[j] = ((const float4*)gf)[F.lane + 64 * j];
    int m = F.gw;
    if (m < T) { const u32x2* xr = (const u32x2*)(X2 + (size_t)m * D); const u32x2* y0 = (const u32x2*)(Y2 + (size_t)(2 * m) * D); const u32x2* y1 = (const u32x2*)(Y2 + (size_t)(2 * m + 1) * D);
#pragma unroll
        for (int j = 0; j < 8; ++j) { xa[j] = __builtin_nontemporal_load(xr + F.lane + 64 * j); ya[j] = __builtin_nontemporal_load(y0 + F.lane + 64 * j); yb[j] = __builtin_nontemporal_load(y1 + F.lane + 64 * j); } }
    for (; m < T; m += F.NGW) {
        const int mn = m + F.NGW;
        if (mn < T) { const u32x2* xr = (const u32x2*)(X2 + (size_t)mn * D); const u32x2* y0 = (const u32x2*)(Y2 + (size_t)(2 * mn) * D); const u32x2* y1 = (const u32x2*)(Y2 + (size_t)(2 * mn + 1) * D);
#pragma unroll
            for (int j = 0; j < 8; ++j) { xn[j] = __builtin_nontemporal_load(xr + F.lane + 64 * j); yan[j] = __builtin_nontemporal_load(y0 + F.lane + 64 * j); ybn[j] = __builtin_nontemporal_load(y1 + F.lane + 64 * j); } }
        f32x4 v[8]; float ss = 0.f;
#pragma unroll
        for (int j = 0; j < 8; ++j) { const u32x2 a2 = xa[j], b = ya[j], c = yb[j];
            v[j] = (f32x4){bf_lo(a2.x) + (bf_lo(b.x) + bf_lo(c.x)), bf_hi(a2.x) + (bf_hi(b.x) + bf_hi(c.x)), bf_lo(a2.y) + (bf_lo(b.y) + bf_lo(c.y)), bf_hi(a2.y) + (bf_hi(b.y) + bf_hi(c.y))};
            ss += v[j].x * v[j].x + v[j].y * v[j].y + v[j].z * v[j].z + v[j].w * v[j].w; }
        const float r = rsqrtf(wave_sum(ss) * (1.f / D) + EPS);
        f32x4* orow = (f32x4*)(F.out + (size_t)m * D);
#pragma unroll
        for (int j = 0; j < 8; ++j) { const float4 g = gw[j]; __builtin_nontemporal_store((f32x4){v[j].x * r * g.x, v[j].y * r * g.y, v[j].z * r * g.z, v[j].w * r * g.w}, orow + F.lane + 64 * j); }
#pragma unroll
        for (int j = 0; j < 8; ++j) { xa[j] = xn[j]; ya[j] = yan[j]; yb[j] = ybn[j]; }
    }
}

constexpr int NPHASE = 10;
__global__ void __launch_bounds__(NTHR, 2) fwd(Args args) {
    extern __shared__ __attribute__((aligned(16))) unsigned char lds_raw[];
    const int wv = __builtin_amdgcn_readfirstlane((int)threadIdx.x >> 6);
    LAS unsigned char* lds0 = (LAS unsigned char*)lds_raw;
    volatile LAS unsigned* xbw = (volatile LAS unsigned*)(lds0 + LDS_BYTES - 16);
    if (wv == 0 && lane_id() == 0) { xbw[0] = 0u; xbw[1] = 0u; }
    __syncthreads();
    unsigned* barw = (unsigned*)(args.ws + WS_CTL) + CW_BAR + args.li * XCD_BAR_WORDS;
    XcdBarrier bar; bar.bar = barw; bar.x = 0; bar.st = xbw; bar.wave = wv;
    const int lo = args.ph_lo, hi = args.ph_hi;
    if (hi - lo > 1) bar = xcd_barrier_post(barw, xbw, wv);
#define IN(k) (lo <= (k) && (k) < hi)
#define SEAM(k) do { if (IN(k) && IN((k) + 1)) xcd_barrier(bar); } while (0)
    if (IN(0)) ph_prologue(relocal(wv));          SEAM(0);
    if (IN(1)) ph_inproj(relocal(wv));            SEAM(1);
    if (IN(2)) ph_hgrn_rec(relocal(wv));          SEAM(2);
    if (IN(3)) ph_hgrn_norm_cmp1(relocal(wv));    if (IN(3) && IN(4)) __syncthreads();
    if (IN(4)) ph_attn(relocal(wv));              SEAM(4);
    if (IN(5)) ph_outproj(relocal(wv));           SEAM(5);
    if (IN(6)) ph_router_logits(relocal(wv));     SEAM(6);
    if (IN(7)) ph_moe1(relocal(wv));              SEAM(7);
    if (IN(8)) ph_moe2(relocal(wv));              SEAM(8);
    if (IN(9)) ph_final(relocal(wv));
#undef IN
#undef SEAM
}

extern "C" void kernel_launch(void* const* d_in, const int* in_sizes, int n_in, void* d_out, int out_size, void* d_ws, size_t ws_size, hipStream_t stream) {
    static int grid = 0;
    if (grid == 0) {
        if (n_in != 22 || out_size != T * D || ws_size < WS_END) { fprintf(stderr, "kernel_launch: unexpected shapes: n_in %d out %d ws %zu (need %zu)\n", n_in, out_size, ws_size, (size_t)WS_END); grid = -1; return; }
        int dev = 0, cus = 0, per_cu = 0;
        if (hipGetDevice(&dev) != hipSuccess || hipDeviceGetAttribute(&cus, hipDeviceAttributeMultiprocessorCount, dev) != hipSuccess) { grid = -1; return; }
        if (hipFuncSetAttribute((const void*)fwd, hipFuncAttributeMaxDynamicSharedMemorySize, LDS_BYTES) != hipSuccess) { fprintf(stderr, "kernel_launch: hipFuncSetAttribute failed\n"); grid = -1; return; }
        if (hipOccupancyMaxActiveBlocksPerMultiprocessor(&per_cu, (const void*)fwd, NTHR, LDS_BYTES) != hipSuccess || per_cu < 1) fprintf(stderr, "kernel_launch: occupancy query says %d\n", per_cu);
        (void)hipGetLastError();
        grid = cus;
    }
    if (grid < 0) return;
    (void)hipMemsetAsync((char*)d_ws + WS_CTL, 0, CTL_BYTES, stream);
    Args a{};
    for (int i = 0; i < 22; ++i) a.in[i] = (const float*)d_in[i];
    a.out = (float*)d_out; a.ws = (unsigned char*)d_ws;
#if MK_ONE_LAUNCH
    a.ph_lo = 0; a.ph_hi = NPHASE;
    hipLaunchKernelGGL(fwd, dim3(grid), dim3(NTHR), LDS_BYTES, stream, a);
#else
    for (int p = 0; p < NPHASE; ++p) { a.ph_lo = p; a.ph_hi = p + 1; hipLaunchKernelGGL(fwd, dim3(grid), dim3(NTHR), LDS_BYTES, stream, a); }
#endif
}
```
